# Optimizing an MI355X kernel written in HIP

```python
import jax
import jax.numpy as jnp
from jax import lax
import numpy as np

D_MODEL = 1024
BATCH = 16
SEQ = 2048
DEPTH = 2

GRID_W = 64
CTX_LEN = 256
HEAD_DIM = 64
ROPE_BASE = 10000.0
EPS = 1e-6
NEG_INF = -1e30

ATT_HEADS = 8
ATT_KV_HEADS = 2
ATT_WIDTH = ATT_HEADS * HEAD_DIM
KV_WIDTH = ATT_KV_HEADS * HEAD_DIM
WINDOW = 128
BLOCK = 128

RET_HEADS = 4
RET_WIDTH = RET_HEADS * HEAD_DIM
RET_CHUNK = 128

CONV_WIDTH = D_MODEL - ATT_WIDTH - RET_WIDTH
CONV_KERNEL = 31
CONV_PAD = CONV_KERNEL // 2

MIX_WIDTH = ATT_WIDTH + RET_WIDTH + CONV_WIDTH
PROJ_SIZES = (ATT_WIDTH, KV_WIDTH, KV_WIDTH, RET_WIDTH, RET_WIDTH, RET_WIDTH, RET_WIDTH, 2 * CONV_WIDTH)
IN_COLS = ATT_WIDTH + 2 * KV_WIDTH + 4 * RET_WIDTH + 2 * CONV_WIDTH

N_EXPERTS = 16
CAPACITY_FACTOR = 2
D_FF = 2816

kernel_name = "hybrid_dit_window_gqa_retention_conformer_ecmoe"


def rms_norm(x, g):
    xf = x.astype(jnp.float32)
    y = xf * lax.rsqrt(jnp.mean(xf * xf, axis=-1, keepdims=True) + EPS)
    return (y * g.astype(jnp.float32)).astype(x.dtype)


def modulate(h, shift, scale):
    return h * (1 + scale) + shift


def heads(t, n):
    return t.reshape(t.shape[:-1] + (n, HEAD_DIM))


def split_proj(u):
    cuts = [int(s) for s in np.cumsum(PROJ_SIZES)[:-1]]
    return jnp.split(u, cuts, axis=-1)


def rotary(x, pos):
    half = x.shape[-1] // 2
    inv = ROPE_BASE ** (-jnp.arange(half, dtype=jnp.float32) / half)
    ang = pos[:, None] * inv[None, :]
    cos = jnp.cos(ang)[:, None, :]
    sin = jnp.sin(ang)[:, None, :]
    xf = x.astype(jnp.float32)
    x1, x2 = xf[..., :half], xf[..., half:]
    return jnp.concatenate([x1 * cos - x2 * sin, x1 * sin + x2 * cos], axis=-1).astype(x.dtype)


def axial_rotary(x, rows, cols):
    half = x.shape[-1] // 2
    return jnp.concatenate([rotary(x[..., :half], rows), rotary(x[..., half:], cols)], axis=-1)


def window_attention(q, k, v, k_ctx, v_ctx, sink):
    B, S, H, d = q.shape
    G = H // ATT_KV_HEADS
    nb = S // BLOCK
    W3 = 3 * BLOCK
    C = k_ctx.shape[1]
    scale = d ** -0.5
    qb = q.reshape(B, nb, BLOCK, ATT_KV_HEADS, G, d)
    pad = ((0, 0), (BLOCK, BLOCK), (0, 0), (0, 0))
    kp = jnp.pad(k, pad).reshape(B, nb + 2, BLOCK, ATT_KV_HEADS, d)
    vp = jnp.pad(v, pad).reshape(B, nb + 2, BLOCK, ATT_KV_HEADS, d)
    kw = jnp.concatenate([kp[:, :-2], kp[:, 1:-1], kp[:, 2:]], axis=2)
    vw = jnp.concatenate([vp[:, :-2], vp[:, 1:-1], vp[:, 2:]], axis=2)
    s_loc = jnp.einsum('bnqkgd,bnwkd->bnkgqw', qb, kw).astype(jnp.float32) * scale
    s_ctx = jnp.einsum('bnqkgd,bckd->bnkgqc', qb, k_ctx).astype(jnp.float32) * scale
    a = jnp.arange(BLOCK)[:, None]
    w = jnp.arange(W3)[None, :]
    kpos = jnp.arange(nb)[:, None, None] * BLOCK - BLOCK + w[None]
    valid = (jnp.abs(w - BLOCK - a)[None] <= WINDOW) & (kpos >= 0) & (kpos < S)
    s_loc = jnp.where(valid[None, :, None, None], s_loc, NEG_INF)
    sink_b = jnp.broadcast_to(sink.astype(jnp.float32).reshape(1, 1, ATT_KV_HEADS, G, 1, 1),
                              s_loc.shape[:-1] + (1,))
    p = jax.nn.softmax(jnp.concatenate([s_loc, s_ctx, sink_b], axis=-1), axis=-1).astype(v.dtype)
    out = (jnp.einsum('bnkgqw,bnwkd->bnqkgd', p[..., :W3], vw)
           + jnp.einsum('bnkgqc,bckd->bnqkgd', p[..., W3:W3 + C], v_ctx))
    return out.reshape(B, S, H * d)


def context_attention(q, k, v, sink):
    B, C, H, d = q.shape
    G = H // ATT_KV_HEADS
    qg = q.reshape(B, C, ATT_KV_HEADS, G, d)
    s = jnp.einsum('bqkgd,bckd->bkgqc', qg, k).astype(jnp.float32) * (d ** -0.5)
    sink_b = jnp.broadcast_to(sink.astype(jnp.float32).reshape(1, ATT_KV_HEADS, G, 1, 1), s.shape[:-1] + (1,))
    p = jax.nn.softmax(jnp.concatenate([s, sink_b], axis=-1), axis=-1)[..., :C].astype(v.dtype)
    return jnp.einsum('bkgqc,bckd->bqkgd', p, v).reshape(B, C, H * d)


def retention_dir(q, k, v, log_gamma, s0, inclusive):
    B, L, H, d = q.shape
    T = RET_CHUNK
    n = L // T
    qc = q.reshape(B, n, T, H, d)
    kc = k.reshape(B, n, T, H, d)
    vc = v.reshape(B, n, T, H, d)
    i = jnp.arange(T, dtype=jnp.float32)
    diff = i[:, None] - i[None, :]
    mask = (diff >= 0) if inclusive else (diff > 0)
    dec = jnp.where(mask[None], jnp.exp(log_gamma[:, None, None] * jnp.maximum(diff, 0.0)[None]), 0.0)
    s = jnp.einsum('bnihd,bnjhd->bnhij', qc, kc) * dec[None, None]
    o_intra = jnp.einsum('bnhij,bnjhd->bnihd', s, vc)
    k_dec = jnp.exp((T - 1 - i)[:, None] * log_gamma[None, :])
    kv = jnp.einsum('bnjhd,jh,bnjhe->bnhde', kc, k_dec, vc)
    chunk_decay = jnp.exp(log_gamma * T)[None, :, None, None]

    def step(state, kv_n):
        return chunk_decay * state + kv_n, state

    s_final, s_prev = lax.scan(step, s0, jnp.moveaxis(kv, 1, 0))
    s_prev = jnp.moveaxis(s_prev, 0, 1)
    q_dec = jnp.exp((i + 1.0)[:, None] * log_gamma[None, :])
    o_inter = jnp.einsum('bnihd,ih,bnhde->bnihe', qc, q_dec, s_prev)
    return (o_intra + o_inter).reshape(B, L, H, d), s_final


def retention_bidir(q_c, k_c, v_c, q_l, k_l, v_l, log_g_f, log_g_b):
    f32 = jnp.float32
    q_c, k_c, v_c, q_l, k_l, v_l = (t.astype(f32) for t in (q_c, k_c, v_c, q_l, k_l, v_l))
    B, _, H, d = q_l.shape
    zeros = jnp.zeros((B, H, d, d), f32)
    rev = lambda t: t[:, ::-1]
    o_cf, s_cf = retention_dir(q_c, k_c, v_c, log_g_f, zeros, True)
    o_cb, s_cb = retention_dir(rev(q_c), rev(k_c), rev(v_c), log_g_b, zeros, False)
    o_lf, _ = retention_dir(q_l, k_l, v_l, log_g_f, s_cf, True)
    o_lb, _ = retention_dir(rev(q_l), rev(k_l), rev(v_l), log_g_b, s_cb, False)
    return o_cf + rev(o_cb), o_lf + rev(o_lb)


def retention_out(o, gate, g):
    B, L, H, d = o.shape
    mu = jnp.mean(o, axis=-1, keepdims=True)
    var = jnp.mean(jnp.square(o - mu), axis=-1, keepdims=True)
    y = ((o - mu) * lax.rsqrt(var + EPS)).reshape(B, L, H * d) * g.astype(jnp.float32)
    return y.astype(gate.dtype) * jax.nn.silu(gate)


def conformer_conv(u, w_dw, b_dw, g, b):
    val, gt = jnp.split(u, 2, axis=-1)
    h = val * jax.nn.sigmoid(gt)
    h = lax.conv_general_dilated(h, w_dw[:, None, :].astype(h.dtype), window_strides=(1,),
                                 padding=((CONV_PAD, CONV_PAD),),
                                 dimension_numbers=('NWC', 'WIO', 'NWC'),
                                 feature_group_count=CONV_WIDTH) + b_dw
    hf = h.astype(jnp.float32)
    mu = jnp.mean(hf, axis=-1, keepdims=True)
    var = jnp.mean(jnp.square(hf - mu), axis=-1, keepdims=True)
    y = (hf - mu) * lax.rsqrt(var + EPS) * g.astype(jnp.float32) + b.astype(jnp.float32)
    return jax.nn.silu(y).astype(u.dtype)


def expert_choice_ffn(h, w_router, w_gate, w_up, w_down):
    B, L, D = h.shape
    cap = CAPACITY_FACTOR * L // N_EXPERTS
    aff = jax.nn.softmax(jnp.einsum('bld,de->ble', h, w_router).astype(jnp.float32), axis=-1)
    g, idx = lax.top_k(jnp.swapaxes(aff, 1, 2), cap)
    xe = jax.vmap(lambda hb, ib: hb[ib])(h, idx)
    a = jnp.einsum('becd,edf->becf', xe, w_gate)
    u = jnp.einsum('becd,edf->becf', xe, w_up)
    y = jnp.einsum('becf,efd->becd', jax.nn.silu(a) * u, w_down) * g[..., None].astype(h.dtype)
    return jax.vmap(lambda ib, yb: jnp.zeros((L, D), yb.dtype).at[ib.reshape(-1)].add(yb.reshape(-1, D)))(idx, y)


def setup_inputs(seed: int = 0) -> dict:
    key = jax.random.key(seed)
    ks = jax.random.split(key, 24)
    f32 = jnp.float32
    nrm = lambda k, shape, s: jax.random.normal(k, shape, f32) * s
    D = D_MODEL
    gamma0 = 1.0 - 2.0 ** (-5.0 - jnp.arange(RET_HEADS, dtype=f32))
    return {
        "x": nrm(ks[0], (BATCH, SEQ, D), 1.0),
        "c": nrm(ks[1], (BATCH, D), 1.0),
        "ctx": nrm(ks[2], (BATCH, CTX_LEN, D), 1.0),
        "c_ctx": nrm(ks[3], (D,), 1.0),
        "w_mod": nrm(ks[4], (DEPTH, D, 6 * D), 0.5 * D ** -0.5),
        "b_mod": nrm(ks[5], (DEPTH, 6 * D), 0.02),
        "g_mix": 1.0 + nrm(ks[6], (DEPTH, D), 0.02),
        "g_ffn": 1.0 + nrm(ks[7], (DEPTH, D), 0.02),
        "w_in": nrm(ks[8], (DEPTH, D, IN_COLS), D ** -0.5),
        "q_norm_g": 1.0 + nrm(ks[9], (DEPTH, HEAD_DIM), 0.02),
        "k_norm_g": 1.0 + nrm(ks[10], (DEPTH, HEAD_DIM), 0.02),
        "att_sink": nrm(ks[11], (DEPTH, ATT_HEADS), 0.5),
        "ret_decay_logit": jnp.log(gamma0 / (1.0 - gamma0)) + nrm(ks[12], (DEPTH, 2, RET_HEADS), 0.1),
        "ret_norm_g": 1.0 + nrm(ks[13], (DEPTH, RET_WIDTH), 0.02),
        "conv_w": nrm(ks[14], (DEPTH, CONV_KERNEL, CONV_WIDTH), CONV_KERNEL ** -0.5),
        "conv_b": nrm(ks[15], (DEPTH, CONV_WIDTH), 0.02),
        "conv_norm_g": 1.0 + nrm(ks[16], (DEPTH, CONV_WIDTH), 0.02),
        "conv_norm_b": nrm(ks[17], (DEPTH, CONV_WIDTH), 0.02),
        "w_out": nrm(ks[18], (DEPTH, MIX_WIDTH, D), MIX_WIDTH ** -0.5),
        "w_router": nrm(ks[19], (DEPTH, D, N_EXPERTS), D ** -0.5),
        "w_gate": nrm(ks[20], (DEPTH, N_EXPERTS, D, D_FF), D ** -0.5),
        "w_up": nrm(ks[21], (DEPTH, N_EXPERTS, D, D_FF), D ** -0.5),
        "w_down": nrm(ks[22], (DEPTH, N_EXPERTS, D_FF, D), D_FF ** -0.5),
    }


def reference(x, c, ctx, c_ctx, w_mod, b_mod, g_mix, g_ffn, w_in, q_norm_g, k_norm_g, att_sink,
              ret_decay_logit, ret_norm_g, conv_w, conv_b, conv_norm_g, conv_norm_b, w_out,
              w_router, w_gate, w_up, w_down):
    f32 = jnp.float32
    B, S, D = x.shape
    C = ctx.shape[1]
    n_rows = S // GRID_W
    rows = jnp.repeat(jnp.arange(n_rows), GRID_W).astype(f32)
    cols = jnp.tile(jnp.arange(GRID_W), n_rows).astype(f32)
    pos_ctx = jnp.arange(C, dtype=f32)
    pos_lat = C + jnp.arange(S, dtype=f32)
    xc = ctx
    cs = jax.nn.silu(c)
    ccs = jax.nn.silu(c_ctx)
    for l in range(DEPTH):
        last = l == DEPTH - 1
        mod_l = (cs @ w_mod[l] + b_mod[l])[:, None, :]
        mod_c = (ccs @ w_mod[l] + b_mod[l])[None, None, :]
        sh_a, sc_a, gt_a, sh_f, sc_f, gt_f = jnp.split(mod_l, 6, axis=-1)
        csh_a, csc_a, cgt_a, csh_f, csc_f, cgt_f = jnp.split(mod_c, 6, axis=-1)

        h_l = modulate(rms_norm(x, g_mix[l]), sh_a, sc_a)
        h_c = modulate(rms_norm(xc, g_mix[l]), csh_a, csc_a)
        aq_l, ak_l, av_l, rq_l, rk_l, rv_l, rg_l, cv_l = split_proj(h_l @ w_in[l])
        aq_c, ak_c, av_c, rq_c, rk_c, rv_c, rg_c, cv_c = split_proj(h_c @ w_in[l])

        k_att_c = rms_norm(heads(ak_c, ATT_KV_HEADS), k_norm_g[l])
        v_att_c = heads(av_c, ATT_KV_HEADS)
        q_att_l = axial_rotary(rms_norm(heads(aq_l, ATT_HEADS), q_norm_g[l]), rows, cols)
        k_att_l = axial_rotary(rms_norm(heads(ak_l, ATT_KV_HEADS), k_norm_g[l]), rows, cols)
        att_l = window_attention(q_att_l, k_att_l, heads(av_l, ATT_KV_HEADS), k_att_c, v_att_c, att_sink[l])

        log_g = jax.nn.log_sigmoid(ret_decay_logit[l].astype(f32))
        kscale = HEAD_DIM ** -0.5
        o_c, o_l = retention_bidir(
            rotary(heads(rq_c, RET_HEADS), pos_ctx), rotary(heads(rk_c, RET_HEADS), pos_ctx) * kscale,
            heads(rv_c, RET_HEADS),
            rotary(heads(rq_l, RET_HEADS), pos_lat), rotary(heads(rk_l, RET_HEADS), pos_lat) * kscale,
            heads(rv_l, RET_HEADS), log_g[0], log_g[1])
        ret_l = retention_out(o_l, rg_l, ret_norm_g[l])

        conv_l = conformer_conv(cv_l, conv_w[l], conv_b[l], conv_norm_g[l], conv_norm_b[l])

        mix_l = jnp.concatenate([att_l, ret_l, conv_l], axis=-1) @ w_out[l]
        x_mid = x + gt_a * mix_l

        if not last:
            q_att_c = rms_norm(heads(aq_c, ATT_HEADS), q_norm_g[l])
            att_c = context_attention(q_att_c, k_att_c, v_att_c, att_sink[l])
            ret_c = retention_out(o_c, rg_c, ret_norm_g[l])
            conv_c = conformer_conv(cv_c, conv_w[l], conv_b[l], conv_norm_g[l], conv_norm_b[l])
            xc = xc + cgt_a * (jnp.concatenate([att_c, ret_c, conv_c], axis=-1) @ w_out[l])
            hf_c = modulate(rms_norm(xc, g_ffn[l]), csh_f, csc_f)
            xc = xc + cgt_f * expert_choice_ffn(hf_c, w_router[l], w_gate[l], w_up[l], w_down[l])

        hf_l = modulate(rms_norm(x_mid, g_ffn[l]), sh_f, sc_f)
        x = x_mid + gt_f * expert_choice_ffn(hf_l, w_router[l], w_gate[l], w_up[l], w_down[l])
    return x
```

```cpp
#include <hip/hip_runtime.h>
#include <cstdio>
#ifdef O_HOST_TEST
#include <math.h>
#include <stdint.h>
#include <stddef.h>
typedef int hipStream_t;
#define HD_ static inline
#else
#include <hip/hip_runtime.h>
#include <math.h>
#include <stdint.h>
#define HD_ __host__ __device__ __forceinline__
#endif

#ifdef O_HOST_TEST
#define HD_MEMBER
#else
#define HD_MEMBER __host__ __device__
#endif
struct Dims {
    int B, S, C, D, DEPTH, GRID_W, AH, KVH, RH, E, FF;
    int AW, KVW, RW, CW, INC, NR, NL, NCc, NCl, NCH, capL, capC, NSL, NSC, G;
    int oAQ, oAK, oAV, oRQ, oRK, oRV, oRG, oCV;
    HD_MEMBER void derive() {
        AW = AH * 64; KVW = KVH * 64; RW = RH * 64; CW = D - AW - RW; INC = AW + 2 * KVW + 4 * RW + 2 * CW;
        NL = B * S; NR = B * (S + C); NCc = C / 128; NCl = S / 128; NCH = NCc + NCl;
        capL = 2 * S / E; capC = 2 * C / E; NSL = B * E * capL; NSC = B * E * capC; G = AH / KVH;
        oAQ = 0; oAK = AW; oAV = AW + KVW; oRQ = AW + 2 * KVW; oRK = oRQ + RW; oRV = oRK + RW; oRG = oRV + RW; oCV = oRG + RW;
    }
};

struct OP {
    Dims d;
    const float *x, *c, *ctx, *c_ctx, *w_mod, *b_mod, *g_mix, *g_ffn, *w_in, *q_norm_g, *k_norm_g, *att_sink, *ret_decay_logit,
        *ret_norm_g, *conv_w, *conv_b, *conv_norm_g, *conv_norm_b, *w_out, *w_router, *w_gate, *w_up, *w_down;
    float *mod;
    float *xcur;
    float *rstd;
    float *h;
    float *u;
    float *qa;
    float *ka;
    float *rq, *rk;
    float *kvinc, *sprev;
    float *hglu, *cbuf;
    float *cstat;
    float *mixin;
    float *mixo;
    float *aff;
    int *rowidx;
    float *gate;
    int *slotof;
    float *hmid;
    float *ybuf;
    float *out;
    int l, last, which;
    int s0, s1;
    int r0, r1;
    const float *gA, *gW; float *gC; int gM, gN, gK, lda, ldw, ldc;
};

HD_ float o_silu(float x) { return x / (1.0f + expf(-x)); }
HD_ float o_sigmoid(float x) { return 1.0f / (1.0f + expf(-x)); }
HD_ void o_rowinfo(const Dims& d, int r, int& kind, int& b, int& t, int& L) {
    if (r < d.NL) { kind = 0; b = r / d.S; t = r % d.S; L = d.S; } else { const int rc = r - d.NL; kind = 1; b = rc / d.C; t = rc % d.C; L = d.C; }
}
HD_ int o_rowof(const Dims& d, int kind, int b, int t) { return kind == 0 ? b * d.S + t : d.NL + b * d.C + t; }
HD_ int o_modidx(const Dims& d, int r) { return r < d.NL ? r / d.S : d.B; }

HD_ void o_mod(const OP& p, long i) {
    const Dims& d = p.d; const int D6 = 6 * d.D; const int j = (int)(i % D6); const int s = (int)((i / D6) % (d.B + 1)); const int l = (int)(i / ((long)D6 * (d.B + 1)));
    const float* cv = s < d.B ? p.c + (size_t)s * d.D : p.c_ctx; const float* w = p.w_mod + (size_t)l * d.D * D6;
    float acc = 0.f; for (int k = 0; k < d.D; ++k) acc += o_silu(cv[k]) * w[(size_t)k * D6 + j];
    p.mod[i] = acc + p.b_mod[(size_t)l * D6 + j];
}
HD_ void o_copyx(const OP& p, long i) { const long nl = (long)p.d.NL * p.d.D; p.xcur[i] = i < nl ? p.x[i] : p.ctx[i - nl]; }
HD_ void o_rstd(const OP& p, long r) { const int D = p.d.D; const float* xr = p.xcur + (size_t)r * D; float s = 0.f; for (int k = 0; k < D; ++k) s += xr[k] * xr[k]; p.rstd[r] = 1.0f / sqrtf(s / D + 1e-6f); }
HD_ void o_normmod(const OP& p, long i) {
    const Dims& d = p.d; const int j = (int)(i % d.D); const int r = (int)(i / d.D);
    const float* g = (p.which ? p.g_ffn : p.g_mix) + (size_t)p.l * d.D; const float* m = p.mod + ((size_t)p.l * (d.B + 1) + o_modidx(d, r)) * 6 * d.D;
    const float sh = m[(p.which ? 3 : 0) * d.D + j], sc = m[(p.which ? 4 : 1) * d.D + j];
    p.h[i] = p.xcur[i] * p.rstd[r] * g[j] * (1.0f + sc) + sh;
}
HD_ void o_gemm(const OP& p, long i) {
    const int nt = p.gN / 4; const int tn = (int)(i % nt), tm = (int)(i / nt);
    float acc[4][4] = {{0.f}};
    const float* a0 = p.gA + (size_t)(tm * 4) * p.lda; const float* w0 = p.gW + tn * 4;
    for (int k = 0; k < p.gK; ++k) {
        const float b0 = w0[(size_t)k * p.ldw + 0], b1 = w0[(size_t)k * p.ldw + 1], b2 = w0[(size_t)k * p.ldw + 2], b3 = w0[(size_t)k * p.ldw + 3];
#pragma unroll
        for (int m = 0; m < 4; ++m) { const float a = a0[(size_t)m * p.lda + k]; acc[m][0] += a * b0; acc[m][1] += a * b1; acc[m][2] += a * b2; acc[m][3] += a * b3; }
    }
#pragma unroll
    for (int m = 0; m < 4; ++m)
#pragma unroll
        for (int n = 0; n < 4; ++n) p.gC[(size_t)(tm * 4 + m) * p.ldc + tn * 4 + n] = acc[m][n];
}
HD_ void o_attprep(const OP& p, long i) {
    const Dims& d = p.d; const int nh = d.AH + d.KVH; const int hh = (int)(i % nh); const int r = (int)(i / nh);
    int kind, b, t, L; o_rowinfo(d, r, kind, b, t, L);
    const bool isq = hh < d.AH; const int hi = isq ? hh : hh - d.AH;
    const float* src = p.u + (size_t)r * d.INC + (isq ? d.oAQ : d.oAK) + hi * 64;
    const float* g = (isq ? p.q_norm_g : p.k_norm_g) + (size_t)p.l * 64;
    float* dst = (isq ? p.qa + (size_t)r * d.AW : p.ka + (size_t)r * d.KVW) + hi * 64;
    float ss = 0.f; for (int k = 0; k < 64; ++k) ss += src[k] * src[k];
    const float rs = 1.0f / sqrtf(ss / 64.0f + 1e-6f);
    if (kind == 1) { for (int k = 0; k < 64; ++k) dst[k] = src[k] * rs * g[k]; return; }
    const float prow = (float)(t / d.GRID_W), pcol = (float)(t % d.GRID_W);
    for (int j = 0; j < 16; ++j) {
        const float inv = powf(10000.0f, -(float)j / 16.0f);
        { const float ang = prow * inv, cs = cosf(ang), sn = sinf(ang); const float x1 = src[j] * rs * g[j], x2 = src[j + 16] * rs * g[j + 16]; dst[j] = x1 * cs - x2 * sn; dst[j + 16] = x1 * sn + x2 * cs; }
        { const float ang = pcol * inv, cs = cosf(ang), sn = sinf(ang); const float x1 = src[32 + j] * rs * g[32 + j], x2 = src[48 + j] * rs * g[48 + j]; dst[32 + j] = x1 * cs - x2 * sn; dst[48 + j] = x1 * sn + x2 * cs; }
    }
}
HD_ void o_retprep(const OP& p, long i) {
    const Dims& d = p.d; const int nh = 2 * d.RH; const int hh = (int)(i % nh); const int r = (int)(i / nh);
    int kind, b, t, L; o_rowinfo(d, r, kind, b, t, L);
    const bool isq = hh < d.RH; const int hi = isq ? hh : hh - d.RH;
    const float* src = p.u + (size_t)r * d.INC + (isq ? d.oRQ : d.oRK) + hi * 64; float* dst = (isq ? p.rq : p.rk) + (size_t)r * d.RW + hi * 64;
    const float pos = (float)(kind == 1 ? t : d.C + t); const float sc = isq ? 1.0f : 0.125f;
    for (int j = 0; j < 32; ++j) { const float inv = powf(10000.0f, -(float)j / 32.0f); const float ang = pos * inv, cs = cosf(ang), sn = sinf(ang);
        const float x1 = src[j], x2 = src[j + 32]; dst[j] = (x1 * cs - x2 * sn) * sc; dst[j + 32] = (x1 * sn + x2 * cs) * sc; }
}
HD_ void o_att(const OP& p, long i) {
    const Dims& d = p.d; const int h = (int)(i % d.AH); const int r = (int)(i / d.AH);
    int kind, b, t, L; o_rowinfo(d, r, kind, b, t, L);
    if (kind == 1 && p.last) return;
    const int kvh = h / d.G; const float* q = p.qa + (size_t)r * d.AW + h * 64;
    float m = p.att_sink[(size_t)p.l * d.AH + h], lsum = 1.0f; float acc[64];
#pragma unroll
    for (int e = 0; e < 64; ++e) acc[e] = 0.f;
    const int nloc = kind == 0 ? 2 * 128 + 1 : 0;
    for (int kk = 0; kk < nloc + d.C; ++kk) {
        int kr;
        if (kk < nloc) { const int kp = t - 128 + kk; if (kp < 0 || kp >= d.S) continue; kr = b * d.S + kp; } else kr = d.NL + b * d.C + (kk - nloc);
        const float* kv = p.ka + (size_t)kr * d.KVW + kvh * 64; const float* vv = p.u + (size_t)kr * d.INC + d.oAV + kvh * 64;
        float s = 0.f;
#pragma unroll
        for (int e = 0; e < 64; ++e) s += q[e] * kv[e];
        s *= 0.125f;
        const float mn = fmaxf(m, s), cf = expf(m - mn), pe = expf(s - mn);
        lsum = lsum * cf + pe; m = mn;
#pragma unroll
        for (int e = 0; e < 64; ++e) acc[e] = acc[e] * cf + pe * vv[e];
    }
    float* dst = p.mixin + (size_t)r * d.D + h * 64; const float il = 1.0f / lsum;
#pragma unroll
    for (int e = 0; e < 64; ++e) dst[e] = acc[e] * il;
}
HD_ int o_scanrow(const Dims& d, int kind, int b, int dir, int n) { const int L = kind ? d.C : d.S; return o_rowof(d, kind, b, dir ? L - 1 - n : n); }
HD_ float o_loggamma(const OP& p, int dir, int head) { const float z = p.ret_decay_logit[((size_t)p.l * 2 + dir) * p.d.RH + head]; return -log1pf(expf(-z)); }
HD_ void o_retkv(const OP& p, long i) {
    const Dims& d = p.d; const int e = (int)(i % 64), dd = (int)((i / 64) % 64); long q = i / 4096; const int head = (int)(q % d.RH); q /= d.RH; const int gc = (int)(q % d.NCH); q /= d.NCH;
    const int dir = (int)(q % 2); const int b = (int)(q / 2);
    const int kind = gc < d.NCc ? 1 : 0; const int ci = kind ? gc : gc - d.NCc; const float lg = o_loggamma(p, dir, head);
    float acc = 0.f;
    for (int j = 0; j < 128; ++j) { const int r = o_scanrow(d, kind, b, dir, ci * 128 + j);
        acc += p.rk[(size_t)r * d.RW + head * 64 + dd] * expf((float)(127 - j) * lg) * p.u[(size_t)r * d.INC + d.oRV + head * 64 + e]; }
    p.kvinc[i] = acc;
}
HD_ void o_retscan(const OP& p, long i) {
    const Dims& d = p.d; const int de = (int)(i % 4096); long q = i / 4096; const int head = (int)(q % d.RH); q /= d.RH; const int dir = (int)(q % 2); const int b = (int)(q / 2);
    const float cd = expf(128.0f * o_loggamma(p, dir, head)); float st = 0.f;
    for (int gc = 0; gc < d.NCH; ++gc) { const size_t o = ((((size_t)b * 2 + dir) * d.NCH + gc) * d.RH + head) * 4096 + de; p.sprev[o] = st; st = cd * st + p.kvinc[o]; }
}
HD_ void o_retout(const OP& p, long i) {
    const Dims& d = p.d; const int head = (int)(i % d.RH); const int r = (int)(i / d.RH);
    int kind, b, t, L; o_rowinfo(d, r, kind, b, t, L);
    if (kind == 1 && p.last) return;
    const float* q = p.rq + (size_t)r * d.RW + head * 64; float o[64];
#pragma unroll
    for (int e = 0; e < 64; ++e) o[e] = 0.f;
    for (int dir = 0; dir < 2; ++dir) {
        const float lg = o_loggamma(p, dir, head); const int n = dir ? L - 1 - t : t; const int ci = n / 128, ii = n % 128; const int gc = kind ? ci : d.NCc + ci;
        const int jend = dir ? ii : ii + 1;
        for (int j = 0; j < jend; ++j) { const int kr = o_scanrow(d, kind, b, dir, ci * 128 + j); const float* kk = p.rk + (size_t)kr * d.RW + head * 64; const float* vv = p.u + (size_t)kr * d.INC + d.oRV + head * 64;
            float s = 0.f;
#pragma unroll
            for (int e = 0; e < 64; ++e) s += q[e] * kk[e];
            s *= expf((float)(ii - j) * lg);
#pragma unroll
            for (int e = 0; e < 64; ++e) o[e] += s * vv[e]; }
        const float qd = expf((float)(ii + 1) * lg); const float* sp = p.sprev + ((((size_t)b * 2 + dir) * d.NCH + gc) * d.RH + head) * 4096;
        for (int dd = 0; dd < 64; ++dd) { const float qv = q[dd] * qd;
#pragma unroll
            for (int e = 0; e < 64; ++e) o[e] += qv * sp[dd * 64 + e]; }
    }
    float mu = 0.f;
#pragma unroll
    for (int e = 0; e < 64; ++e) mu += o[e];
    mu *= (1.0f / 64.0f); float var = 0.f;
#pragma unroll
    for (int e = 0; e < 64; ++e) var += (o[e] - mu) * (o[e] - mu);
    const float rs = 1.0f / sqrtf(var / 64.0f + 1e-6f);
    const float* g = p.ret_norm_g + (size_t)p.l * d.RW + head * 64; const float* gt = p.u + (size_t)r * d.INC + d.oRG + head * 64; float* dst = p.mixin + (size_t)r * d.D + d.AW + head * 64;
#pragma unroll
    for (int e = 0; e < 64; ++e) dst[e] = (o[e] - mu) * rs * g[e] * o_silu(gt[e]);
}
HD_ void o_glu(const OP& p, long i) { const Dims& d = p.d; const int ch = (int)(i % d.CW); const int r = (int)(i / d.CW); const float* ur = p.u + (size_t)r * d.INC + d.oCV; p.hglu[i] = ur[ch] * o_sigmoid(ur[d.CW + ch]); }
HD_ void o_dwconv(const OP& p, long i) {
    const Dims& d = p.d; const int ch = (int)(i % d.CW); const int r = (int)(i / d.CW); int kind, b, t, L; o_rowinfo(d, r, kind, b, t, L);
    float acc = p.conv_b[(size_t)p.l * d.CW + ch];
    for (int j = 0; j < 31; ++j) { const int tt = t + j - 15; if (tt < 0 || tt >= L) continue; acc += p.hglu[(size_t)o_rowof(d, kind, b, tt) * d.CW + ch] * p.conv_w[((size_t)p.l * 31 + j) * d.CW + ch]; }
    p.cbuf[i] = acc;
}
HD_ void o_convstat(const OP& p, long r) { const int CW = p.d.CW; const float* cr = p.cbuf + (size_t)r * CW; float mu = 0.f; for (int k = 0; k < CW; ++k) mu += cr[k]; mu /= CW; float var = 0.f; for (int k = 0; k < CW; ++k) var += (cr[k] - mu) * (cr[k] - mu);
    p.cstat[2 * r] = mu; p.cstat[2 * r + 1] = 1.0f / sqrtf(var / CW + 1e-6f); }
HD_ void o_convout(const OP& p, long i) { const Dims& d = p.d; const int ch = (int)(i % d.CW); const int r = (int)(i / d.CW);
    const float y = (p.cbuf[i] - p.cstat[2 * r]) * p.cstat[2 * r + 1] * p.conv_norm_g[(size_t)p.l * d.CW + ch] + p.conv_norm_b[(size_t)p.l * d.CW + ch];
    p.mixin[(size_t)r * d.D + d.AW + d.RW + ch] = o_silu(y); }
HD_ void o_resid_a(const OP& p, long i) { const Dims& d = p.d; const int j = (int)(i % d.D); const int r = (int)(i / d.D); if (r >= d.NL && p.last) return;
    p.xcur[i] += p.mod[((size_t)p.l * (d.B + 1) + o_modidx(d, r)) * 6 * d.D + 2 * d.D + j] * p.mixo[i]; }
HD_ void o_router(const OP& p, long r) {
    const Dims& d = p.d; if (r >= d.NL && p.last) return;
    float lg[16]; const float* hr = p.h + (size_t)r * d.D; const float* w = p.w_router + (size_t)p.l * d.D * d.E;
#pragma unroll
    for (int e = 0; e < 16; ++e) lg[e] = 0.f;
    for (int k = 0; k < d.D; ++k) { const float hv = hr[k];
#pragma unroll
        for (int e = 0; e < 16; ++e) lg[e] += hv * w[(size_t)k * 16 + e]; }
    float m = lg[0];
#pragma unroll
    for (int e = 1; e < 16; ++e) m = fmaxf(m, lg[e]);
    float s = 0.f;
#pragma unroll
    for (int e = 0; e < 16; ++e) { lg[e] = expf(lg[e] - m); s += lg[e]; }
#pragma unroll
    for (int e = 0; e < 16; ++e) p.aff[(size_t)r * 16 + e] = lg[e] / s;
}
HD_ void o_topk(const OP& p, long i) {
    const Dims& d = p.d; const int e = (int)(i % d.E); const int r = (int)(i / d.E); int kind, b, t, L; o_rowinfo(d, r, kind, b, t, L);
    if (kind == 1 && p.last) return;
    const float a = p.aff[(size_t)r * d.E + e]; const int r0 = o_rowof(d, kind, b, 0); int rank = 0;
    for (int tt = 0; tt < L; ++tt) { const float o = p.aff[(size_t)(r0 + tt) * d.E + e]; rank += (o > a || (o == a && tt < t)) ? 1 : 0; }
    const int cap = kind ? d.capC : d.capL;
    if (rank < cap) { const int slot = (kind ? d.NSL : 0) + (b * d.E + e) * cap + rank; p.rowidx[slot] = r; p.gate[slot] = a; p.slotof[i] = slot; } else p.slotof[i] = -1;
}
HD_ int o_slot_expert(const Dims& d, int slot) { return slot < d.NSL ? (slot / d.capL) % d.E : ((slot - d.NSL) / d.capC) % d.E; }
HD_ void o_ffn1(const OP& p, long i) {
    const Dims& d = p.d; const int nt = d.FF / 4; const int tn = (int)(i % nt), tm = (int)(i / nt); const int sl = p.s0 + tm * 4; const int e = o_slot_expert(d, sl);
    const float* wg = p.w_gate + ((size_t)p.l * d.E + e) * d.D * d.FF + tn * 4; const float* wu = p.w_up + ((size_t)p.l * d.E + e) * d.D * d.FF + tn * 4;
    const float* ar[4];
#pragma unroll
    for (int m = 0; m < 4; ++m) ar[m] = p.h + (size_t)p.rowidx[sl + m] * d.D;
    float ag[4][4] = {{0.f}}, au[4][4] = {{0.f}};
    for (int k = 0; k < d.D; ++k) {
        float g4[4], u4[4];
#pragma unroll
        for (int n = 0; n < 4; ++n) { g4[n] = wg[(size_t)k * d.FF + n]; u4[n] = wu[(size_t)k * d.FF + n]; }
#pragma unroll
        for (int m = 0; m < 4; ++m) { const float a = ar[m][k];
#pragma unroll
            for (int n = 0; n < 4; ++n) { ag[m][n] += a * g4[n]; au[m][n] += a * u4[n]; } }
    }
#pragma unroll
    for (int m = 0; m < 4; ++m)
#pragma unroll
        for (int n = 0; n < 4; ++n) p.hmid[(size_t)(tm * 4 + m) * d.FF + tn * 4 + n] = o_silu(ag[m][n]) * au[m][n];
}
HD_ void o_ffn2(const OP& p, long i) {
    const Dims& d = p.d; const int nt = d.D / 4; const int tn = (int)(i % nt), tm = (int)(i / nt); const int sl = p.s0 + tm * 4; const int e = o_slot_expert(d, sl);
    const float* wd = p.w_down + ((size_t)p.l * d.E + e) * d.FF * d.D + tn * 4; const float* a0 = p.hmid + (size_t)(tm * 4) * d.FF;
    float acc[4][4] = {{0.f}};
    for (int k = 0; k < d.FF; ++k) {
        float b4[4];
#pragma unroll
        for (int n = 0; n < 4; ++n) b4[n] = wd[(size_t)k * d.D + n];
#pragma unroll
        for (int m = 0; m < 4; ++m) { const float a = a0[(size_t)m * d.FF + k];
#pragma unroll
            for (int n = 0; n < 4; ++n) acc[m][n] += a * b4[n]; }
    }
#pragma unroll
    for (int m = 0; m < 4; ++m) { const float g = p.gate[sl + m];
#pragma unroll
        for (int n = 0; n < 4; ++n) p.ybuf[(size_t)(tm * 4 + m) * d.D + tn * 4 + n] = acc[m][n] * g; }
}
HD_ void o_combine(const OP& p, long i) {
    const Dims& d = p.d; const int j = (int)(i % d.D); const int r = p.r0 + (int)(i / d.D);
    float s = 0.f; for (int e = 0; e < d.E; ++e) { const int sl = p.slotof[(size_t)r * d.E + e]; if (sl >= 0) s += p.ybuf[(size_t)(sl - p.s0) * d.D + j]; }
    const float v = p.xcur[(size_t)r * d.D + j] + p.mod[((size_t)p.l * (d.B + 1) + o_modidx(d, r)) * 6 * d.D + 5 * d.D + j] * s;
    p.xcur[(size_t)r * d.D + j] = v;
    if (p.last && r < d.NL) p.out[(size_t)r * d.D + j] = v;
}

#define O_STAGES(X) X(mod) X(copyx) X(rstd) X(normmod) X(gemm) X(attprep) X(retprep) X(att) X(retkv) X(retscan) X(retout) X(glu) X(dwconv) X(convstat) X(convout) X(resid_a) X(router) X(topk) X(ffn1) X(ffn2) X(combine)
#ifndef O_HOST_TEST
#define O_DEFK(name) __global__ void __launch_bounds__(256) ok_##name(OP p, long n) { for (long i = (long)blockIdx.x * blockDim.x + threadIdx.x; i < n; i += (long)gridDim.x * blockDim.x) o_##name(p, i); }
O_STAGES(O_DEFK)
#endif

#ifdef O_HOST_TEST
#define O_RUN(name, p, n) do { for (long _i = 0; _i < (long)(n); ++_i) o_##name(p, _i); } while (0)
#else
#define O_RUN(name, p, n) do { const long _n = (long)(n); if (_n > 0) { long _g = (_n + 255) / 256; if (_g > 65536) _g = 65536; hipLaunchKernelGGL(ok_##name, dim3((unsigned)_g), dim3(256), 0, stream, p, _n); } } while (0)
#endif

static inline size_t o_carve(OP& p, unsigned char* ws, int ffn_chunk_slots) {
    const Dims& d = p.d; size_t off = 0;
    auto take = [&](size_t bytes) { void* q = ws + off; off += (bytes + 255) & ~(size_t)255; return q; };
    p.mod = (float*)take((size_t)d.DEPTH * (d.B + 1) * 6 * d.D * 4);
    p.xcur = (float*)take((size_t)d.NR * d.D * 4);
    p.rstd = (float*)take((size_t)d.NR * 4);
    p.h = (float*)take((size_t)d.NR * d.D * 4);
    p.mixin = (float*)take((size_t)d.NR * d.D * 4);
    p.aff = (float*)take((size_t)d.NR * d.E * 4);
    p.rowidx = (int*)take((size_t)(d.NSL + d.NSC) * 4);
    p.gate = (float*)take((size_t)(d.NSL + d.NSC) * 4);
    p.slotof = (int*)take((size_t)d.NR * d.E * 4);
    p.qa = (float*)take((size_t)d.NR * d.AW * 4);
    p.ka = (float*)take((size_t)d.NR * d.KVW * 4);
    p.rq = (float*)take((size_t)d.NR * d.RW * 4);
    p.rk = (float*)take((size_t)d.NR * d.RW * 4);
    p.kvinc = (float*)take((size_t)d.B * 2 * d.NCH * d.RH * 4096 * 4);
    p.sprev = (float*)take((size_t)d.B * 2 * d.NCH * d.RH * 4096 * 4);
    p.hglu = (float*)take((size_t)d.NR * d.CW * 4);
    p.cbuf = (float*)take((size_t)d.NR * d.CW * 4);
    p.cstat = (float*)take((size_t)d.NR * 2 * 4);
    const size_t ubytes = (size_t)d.NR * d.INC * 4, fbytes = (size_t)ffn_chunk_slots * (d.FF + d.D) * 4;
    unsigned char* ub = (unsigned char*)take(ubytes > fbytes ? ubytes : fbytes);
    p.u = (float*)ub; p.hmid = (float*)ub; p.ybuf = (float*)(ub + (size_t)ffn_chunk_slots * d.FF * 4);
    p.mixo = p.h;
    return off;
}

static inline void o_forward(OP p, int ffn_chunk_samples, hipStream_t stream) {
    const Dims& d = p.d; (void)stream;
    O_RUN(mod, p, (long)d.DEPTH * (d.B + 1) * 6 * d.D);
    O_RUN(copyx, p, (long)d.NR * d.D);
    for (int l = 0; l < d.DEPTH; ++l) {
        p.l = l; p.last = (l == d.DEPTH - 1);
        p.which = 0; O_RUN(rstd, p, d.NR); O_RUN(normmod, p, (long)d.NR * d.D);
        p.gA = p.h; p.lda = d.D; p.gW = p.w_in + (size_t)l * d.D * d.INC; p.ldw = d.INC; p.gC = p.u; p.ldc = d.INC; p.gM = d.NR; p.gN = d.INC; p.gK = d.D;
        O_RUN(gemm, p, (long)(p.gM / 4) * (p.gN / 4));
        O_RUN(attprep, p, (long)d.NR * (d.AH + d.KVH)); O_RUN(retprep, p, (long)d.NR * 2 * d.RH);
        O_RUN(att, p, (long)d.NR * d.AH);
        O_RUN(retkv, p, (long)d.B * 2 * d.NCH * d.RH * 4096); O_RUN(retscan, p, (long)d.B * 2 * d.RH * 4096); O_RUN(retout, p, (long)d.NR * d.RH);
        O_RUN(glu, p, (long)d.NR * d.CW); O_RUN(dwconv, p, (long)d.NR * d.CW); O_RUN(convstat, p, d.NR); O_RUN(convout, p, (long)d.NR * d.CW);
        const int mrows = p.last ? d.NL : d.NR;
        p.gA = p.mixin; p.lda = d.D; p.gW = p.w_out + (size_t)l * d.D * d.D; p.ldw = d.D; p.gC = p.mixo; p.ldc = d.D; p.gM = mrows; p.gN = d.D; p.gK = d.D;
        O_RUN(gemm, p, (long)(p.gM / 4) * (p.gN / 4));
        O_RUN(resid_a, p, (long)d.NR * d.D);
        p.which = 1; O_RUN(rstd, p, d.NR); O_RUN(normmod, p, (long)d.NR * d.D);
        O_RUN(router, p, d.NR); O_RUN(topk, p, (long)d.NR * d.E);
        for (int b0 = 0; b0 < d.B; b0 += ffn_chunk_samples) {
            p.s0 = b0 * d.E * d.capL; p.s1 = (b0 + ffn_chunk_samples) * d.E * d.capL; p.r0 = b0 * d.S; p.r1 = (b0 + ffn_chunk_samples) * d.S;
            O_RUN(ffn1, p, (long)((p.s1 - p.s0) / 4) * (d.FF / 4)); O_RUN(ffn2, p, (long)((p.s1 - p.s0) / 4) * (d.D / 4)); O_RUN(combine, p, (long)(p.r1 - p.r0) * d.D);
        }
        if (!p.last) {
            p.s0 = d.NSL; p.s1 = d.NSL + d.NSC; p.r0 = d.NL; p.r1 = d.NR;
            O_RUN(ffn1, p, (long)((p.s1 - p.s0) / 4) * (d.FF / 4)); O_RUN(ffn2, p, (long)((p.s1 - p.s0) / 4) * (d.D / 4)); O_RUN(combine, p, (long)(p.r1 - p.r0) * d.D);
        }
    }
}
#include <string.h>
static inline void fill_inputs(OP& p, void* const* d_in) {
    p.x = (const float*)d_in[0]; p.c = (const float*)d_in[1]; p.ctx = (const float*)d_in[2]; p.c_ctx = (const float*)d_in[3]; p.w_mod = (const float*)d_in[4]; p.b_mod = (const float*)d_in[5];
    p.g_mix = (const float*)d_in[6]; p.g_ffn = (const float*)d_in[7]; p.w_in = (const float*)d_in[8]; p.q_norm_g = (const float*)d_in[9]; p.k_norm_g = (const float*)d_in[10]; p.att_sink = (const float*)d_in[11];
    p.ret_decay_logit = (const float*)d_in[12]; p.ret_norm_g = (const float*)d_in[13]; p.conv_w = (const float*)d_in[14]; p.conv_b = (const float*)d_in[15]; p.conv_norm_g = (const float*)d_in[16];
    p.conv_norm_b = (const float*)d_in[17]; p.w_out = (const float*)d_in[18]; p.w_router = (const float*)d_in[19]; p.w_gate = (const float*)d_in[20]; p.w_up = (const float*)d_in[21]; p.w_down = (const float*)d_in[22];
}
extern "C" void kernel_launch(void* const* d_in, const int* in_sizes, int n_in, void* d_out, int out_size, void* d_ws, size_t ws_size, hipStream_t stream) {
    (void)in_sizes; (void)n_in; (void)out_size;
    OP p; memset(&p, 0, sizeof(p)); Dims& d = p.d;
    d.B = 16; d.S = 2048; d.C = 256; d.D = 1024; d.DEPTH = 2; d.GRID_W = 64; d.AH = 8; d.KVH = 2; d.RH = 4; d.E = 16; d.FF = 2816; d.derive();
    fill_inputs(p, d_in);
    const int chunk_samples = 4; const int chunk_slots = chunk_samples * d.E * d.capL;
    const size_t used = o_carve(p, (unsigned char*)d_ws, chunk_slots);
    if (used > ws_size) { fprintf(stderr, "kernel_launch: workspace too small (%zu > %zu)\n", used, ws_size); return; }
    p.out = (float*)d_out;
    o_forward(p, chunk_samples, stream);
}
```

```cpp
#include <hip/hip_runtime.h>
#include <cstdio>
#include <cmath>
#include <cstdint>
#define HD_ __host__ __device__ __forceinline__
struct Dims {
    static constexpr int B = 16, S = 2048, C = 256, D = 1024, DEPTH = 2, GRID_W = 64, AH = 8, KVH = 2, RH = 4, E = 16, FF = 2816;
    static constexpr int AW = AH * 64, KVW = KVH * 64, RW = RH * 64, CW = D - AW - RW, INC = AW + 2 * KVW + 4 * RW + 2 * CW;
    static constexpr int NL = B * S, NR = B * (S + C), NCc = C / 128, NCl = S / 128, NCH = NCc + NCl;
    static constexpr int capL = 2 * S / E, capC = 2 * C / E, NSL = B * E * capL, NSC = B * E * capC, G = AH / KVH;
    static constexpr int oAQ = 0, oAK = AW, oAV = AW + KVW, oRQ = AW + 2 * KVW, oRK = oRQ + RW, oRV = oRK + RW, oRG = oRV + RW, oCV = oRG + RW;
    int pad_;
};

struct OP {
    Dims d;
    const float *x, *c, *ctx, *c_ctx, *w_mod, *b_mod, *g_mix, *g_ffn, *w_in, *q_norm_g, *k_norm_g, *att_sink, *ret_decay_logit,
        *ret_norm_g, *conv_w, *conv_b, *conv_norm_g, *conv_norm_b, *w_out, *w_router, *w_gate, *w_up, *w_down;
    float *mod;
    float *xcur;
    float *u;
    float *aff;
    int *rowidx;
    float *gate;
    int *slotof;
    float *out;
    unsigned short *hbf, *mixbf, *xe, *hmidb, *ybufb, *wInT, *wOutT, *ffnW1, *ffnW2;
};

#define XB_TMO      128
#define XB_XCNT(j)  (256  + 64 * (j))
#define XB_XSUB(j)  (1280 + 64 * (j))
#define XB_XGEN(j)  (2304 + 64 * (j))
#define XB_TOP      3328
#define XB_TOPGEN   3392
#define XCD_BAR_WORDS 3456
#define XB_SPIN_CAP (1u << 18)
#define LAS __attribute__((address_space(3)))

__device__ __forceinline__ unsigned xb_ld(unsigned* p)              { return __hip_atomic_load(p, __ATOMIC_RELAXED, __HIP_MEMORY_SCOPE_AGENT); }
__device__ __forceinline__ unsigned xb_add(unsigned* p, unsigned v) { return __hip_atomic_fetch_add(p, v, __ATOMIC_RELAXED, __HIP_MEMORY_SCOPE_AGENT); }
__device__ __forceinline__ unsigned xb_xcc_id() { return (unsigned)__builtin_amdgcn_s_getreg((3 << 11) | 20) & 0xFu; }
#define XB_SPIN(cond, bar) do { unsigned _sp = 0; while (cond) { __builtin_amdgcn_s_sleep(1); \
    if ((++_sp & 255u) == 0u) { if (xb_ld(&(bar)[XB_TMO])) break; if (_sp > XB_SPIN_CAP) { atomicAdd(&(bar)[XB_TMO], 1u); break; } } } } while (0)

struct XcdBarrier {
    unsigned* bar; unsigned x;
    volatile LAS unsigned* st;
};

__device__ __forceinline__ XcdBarrier xcd_barrier_post(unsigned* bar, volatile LAS unsigned* st) {
    XcdBarrier b; b.bar = bar; b.x = xb_xcc_id(); b.st = st;
    if (threadIdx.x == 0) (void)xb_add(&bar[XB_XCNT(b.x)], 1u);
    return b;
}
__device__ __forceinline__ void xcd_barrier_complete(unsigned* bar, unsigned x, unsigned& nloc, unsigned& nx) {
    const unsigned G = gridDim.x * gridDim.y * gridDim.z;
    unsigned sum, cnt, mine, sp = 0u;
    for (;;) {
        sum = 0u; cnt = 0u; mine = 0u;
#pragma unroll
        for (unsigned j = 0; j < 16; ++j) { const unsigned c = xb_ld(&bar[XB_XCNT(j)]); sum += c; cnt += (c > 0u) ? 1u : 0u; mine = (j == x) ? c : mine; }
        if (sum == G) break;
        __builtin_amdgcn_s_sleep(1);
        if ((++sp & 255u) == 0u) { if (xb_ld(&bar[XB_TMO])) break; if (sp > XB_SPIN_CAP) { atomicAdd(&bar[XB_TMO], 1u); break; } }
    }
    nloc = mine > 0u ? mine : 1u; nx = cnt > 0u ? cnt : 1u;
}

__device__ __forceinline__ void xcd_barrier(const XcdBarrier& b) {
    asm volatile("s_waitcnt vmcnt(0)" ::: "memory");
    __syncthreads();
    if (threadIdx.x == 0) {
        unsigned* bar = b.bar;
        __builtin_amdgcn_s_waitcnt(0);
        unsigned nloc = b.st[0], nx = b.st[1];
        if (nloc == 0u) { xcd_barrier_complete(bar, b.x, nloc, nx); b.st[0] = nloc; b.st[1] = nx; }
        const unsigned old = xb_add(&bar[XB_XSUB(b.x)], 1u);
        const unsigned gen = old / nloc;
        if (old + 1u == (gen + 1u) * nloc) {
            __builtin_amdgcn_fence(__ATOMIC_RELEASE, "agent");
            asm volatile("s_waitcnt vmcnt(0)" ::: "memory");
            const unsigned og = xb_add(&bar[XB_TOP], 1u);
            const unsigned tg = og / nx;
            if (og + 1u == (tg + 1u) * nx) xb_add(&bar[XB_TOPGEN], 1u);
            else XB_SPIN(xb_ld(&bar[XB_TOPGEN]) == tg, bar);
            __builtin_amdgcn_fence(__ATOMIC_ACQUIRE, "agent");
            xb_add(&bar[XB_XGEN(b.x)], 1u);
            asm volatile("s_waitcnt vmcnt(0)" ::: "memory");
        } else {
            XB_SPIN(xb_ld(&bar[XB_XGEN(b.x)]) == gen, bar);
            __builtin_amdgcn_fence(__ATOMIC_ACQUIRE, "agent");
            asm volatile("s_waitcnt vmcnt(0)" ::: "memory");
        }
    }
    __syncthreads();
}
namespace pg8 {
#define PG8_LAS __attribute__((address_space(3)))
typedef unsigned short bf16_t;
typedef short bf16x8 __attribute__((ext_vector_type(8)));
typedef float f32x4 __attribute__((ext_vector_type(4)));
typedef float f32x2 __attribute__((ext_vector_type(2)));
typedef unsigned u32x4 __attribute__((ext_vector_type(4)));
typedef unsigned u32x2 __attribute__((ext_vector_type(2)));
constexpr int BM = 256, BK = 64, HALF = 128, HTB = HALF * BK * 2  , STAGE_BYTES = 8 * HTB, NXCD = 8, WGM = 8;

__host__ __device__ __forceinline__ int lds_byte(int r, int c) { const int st = (r >> 4) * 2 + (c >> 5), rr = r & 15, cc = c & 31, ob = rr * 64 + cc * 2; return st * 1024 + (ob ^ (((ob >> 9) & 1) << 5)); }
__host__ __device__ __forceinline__ void stage_rc(int b, int& R, int& C) { const int st = b / 1024, sb = b % 1024, swz = sb ^ (((sb >> 9) & 1) << 5); R = (st >> 1) * 16 + swz / 64; C = (st & 1) * 32 + (swz % 64) / 2; }
__host__ __device__ __forceinline__ int perm32(int rho) { const int n = rho >> 4, i = rho & 15; return 8 * (i >> 2) + 4 * n + (i & 3); }

struct Unit { int pm, pn, pb; };
struct Gemm { const bf16_t* A; const bf16_t* Bt; int K; const int* ridx; int tbl_off; };

struct DenseOrder {
    int nM, nN, nwg, G, c;
    __device__ void init(int nM_, int nN_, int G_, int c_) { nM = nM_; nN = nN_; nwg = nM * nN; G = G_; c = c_; }
    __device__ bool next(int i, Unit& u) const {
        const long L = (long)i * G + c; if (L >= nwg) return false;
        int wgid = (int)L; { const int q = nwg / NXCD, r = nwg % NXCD, xcd = wgid % NXCD, off = wgid / NXCD; wgid = (xcd < r ? xcd * (q + 1) : r * (q + 1) + (xcd - r) * q) + off; }
        const int nig = WGM * nN, gid = wgid / nig, fm = gid * WGM, gsz = (nM - fm) < WGM ? (nM - fm) : WGM;
        u.pm = fm + ((wgid % nig) % gsz); u.pn = (wgid % nig) / gsz; u.pb = u.pn; return true;
    }
};
struct WinOrder {
    DenseOrder dn; int nLat, nCtx, ncx, cols, G, c;
    __device__ void init(int nLat_, int nCtx_, int nN_, int ncx_, int cols_, int G_, int c_) { dn.init(nLat_, nN_, G_, c_); nLat = nLat_; nCtx = nCtx_; ncx = ncx_; cols = cols_; G = G_; c = c_; }
    __device__ bool next(int i, Unit& u) const {
        const long L = (long)i * G + c; const int nd = dn.nwg;
        if (L < nd) return dn.next(i, u);
        const int idx = (int)(L - nd); if (idx >= nCtx * ncx) return false;
        u.pm = nLat + idx / ncx; u.pn = (cols >> (4 * (idx % ncx))) & 15; u.pb = u.pn; return true;
    }
};
struct ExpertOrder {
    int nN, tpeL, tpeC, nE, G, c, nwg;
    __device__ void init(int nN_, int tpeL_, int tpeC_, int nE_, int G_, int c_) { nN = nN_; tpeL = tpeL_; tpeC = tpeC_; nE = nE_; G = G_; c = c_; nwg = nE * nN * (tpeL + tpeC); }
    __device__ bool next(int i, Unit& u) const {
        const unsigned tpe = (unsigned)(tpeL + tpeC), per = (unsigned)nN * tpe; unsigned e, j;
        if ((G & 7) == 0 && (nE & 7) == 0) { const unsigned Wx = (unsigned)G >> 3, x = (unsigned)c & 7u, r = (unsigned)c >> 3; unsigned jx = (unsigned)i * Wx + r; if (jx >= ((unsigned)nE >> 3) * per) return false;
            const unsigned ei = (jx >= per ? 1u : 0u) + (jx >= 2u * per ? 1u : 0u) + (jx >= 3u * per ? 1u : 0u); e = x + 8u * ei; j = jx - ei * per; }
        else { unsigned L = (unsigned)i * (unsigned)G + (unsigned)c; if (L >= (unsigned)nwg) return false; e = 0u; while (L >= per) { L -= per; ++e; } j = L; }
        const unsigned PW = nN < 8 ? (unsigned)nN : 8u, grp = PW * tpe; const unsigned pg = (j >= grp ? 1u : 0u) + (j >= 2u * grp ? 1u : 0u) + (j >= 3u * grp ? 1u : 0u); j -= pg * grp;
        const unsigned rest = (unsigned)nN - pg * PW, w = rest < PW ? rest : PW;
        unsigned mt;
        if (w == 8u) mt = j >> 3; else if (w == 4u) mt = j >> 2; else if (w == 6u) mt = (j * 10923u) >> 16; else { mt = 0u; for (unsigned t = j; t >= w; t -= w) ++mt; }
        const unsigned pn = pg * PW + (j - mt * w);
        u.pm = (int)(mt < (unsigned)tpeL ? e * (unsigned)tpeL + mt : (unsigned)nE * (unsigned)tpeL + e * (unsigned)tpeC + (mt - (unsigned)tpeL)); u.pn = (int)pn; u.pb = (int)(e * (unsigned)nN + pn); return true;
    }
};

typedef int i32x8 __attribute__((ext_vector_type(8)));
typedef int i32x4 __attribute__((ext_vector_type(4)));
__device__ __forceinline__ i32x8 cat8(const bf16x8 a, const bf16x8 b) { return __builtin_shufflevector(__builtin_bit_cast(i32x4, a), __builtin_bit_cast(i32x4, b), 0, 1, 2, 3, 4, 5, 6, 7); }
__device__ __forceinline__ unsigned pk4_fp8(float a, float b, float c, float d) { int r = 0; r = __builtin_amdgcn_cvt_pk_fp8_f32(a, b, r, false); r = __builtin_amdgcn_cvt_pk_fp8_f32(c, d, r, true); return (unsigned)r; }
__device__ __forceinline__ unsigned cvt_pk_bf16(float lo, float hi) { unsigned r; asm volatile("v_cvt_pk_bf16_f32 %0, %1, %2" : "=v"(r) : "v"(lo), "v"(hi)); return r; }

struct EpiBf16 {
    static constexpr bool PERM = true; static constexpr int NSTORE = 16;
    bf16_t* O; int ldc;
    __device__ __forceinline__ void operator()(const f32x4 (&acc)[2][2][4][2], const Unit& u, int wr, int wc, int fr, int fq) const {
        const int row0 = u.pm * BM + wr * 64 + fr, col0 = u.pn * BM + wc * 32 + 8 * fq;
#pragma unroll
        for (int ai = 0; ai < 2; ++ai)
#pragma unroll
            for (int m = 0; m < 4; ++m) { bf16_t* rowp = O + (size_t)(row0 + ai * HALF + m * 16) * ldc + col0;
#pragma unroll
                for (int bj = 0; bj < 2; ++bj) { const f32x4 v0 = acc[ai][bj][m][0], v1 = acc[ai][bj][m][1];
                    u32x4 w; w.x = cvt_pk_bf16(v0[0], v0[1]); w.y = cvt_pk_bf16(v0[2], v0[3]); w.z = cvt_pk_bf16(v1[0], v1[1]); w.w = cvt_pk_bf16(v1[2], v1[3]);
                    *(u32x4*)(rowp + bj * HALF) = w; } }
    }
};
struct EpiResid {
    static constexpr bool PERM = false; static constexpr int NSTORE = 32;
    float* X; const float* srcL; const float* srcC; int ldc; const float* mod; int gate_off; int NL, S, B;
    __device__ __forceinline__ void operator()(const f32x4 (&acc)[2][2][4][2], const Unit& u, int wr, int wc, int fr, int fq) const {
        const int row0 = u.pm * BM + wr * 64 + fr, col0 = u.pn * BM + wc * 32 + 4 * fq;
        const int rt = u.pm * BM; const int mi = rt < NL ? rt / S : B;
        const float* sb = rt < NL ? srcL : srcC - (size_t)NL * ldc;
        const float* gp = mod + (size_t)mi * 6 * ldc + gate_off + col0;
        f32x4 gv[2][2];
#pragma unroll
        for (int bj = 0; bj < 2; ++bj)
#pragma unroll
            for (int n = 0; n < 2; ++n) gv[bj][n] = *(const f32x4*)(gp + bj * HALF + n * 16);
#pragma unroll
        for (int ai = 0; ai < 2; ++ai)
#pragma unroll
            for (int m = 0; m < 4; ++m) { const size_t ro = (size_t)(row0 + ai * HALF + m * 16) * ldc + col0;
#pragma unroll
                for (int bj = 0; bj < 2; ++bj)
#pragma unroll
                    for (int n = 0; n < 2; ++n) *(f32x4*)(X + ro + bj * HALF + n * 16) = *(const f32x4*)(sb + ro + bj * HALF + n * 16) + gv[bj][n] * acc[ai][bj][m][n]; }
    }
};
__device__ __forceinline__ float silu_f(float x) { return x * __builtin_amdgcn_rcpf(1.0f + __expf(-x)); }
struct EpiSwiGLU8 {
    static constexpr bool PERM = true; static constexpr int NSTORE = 8;
    unsigned char* H; int ldh; float iscale, oscale;
    __device__ __forceinline__ void operator()(const f32x4 (&acc)[2][2][4][2], const Unit& u, int wr, int wc, int fr, int fq) const {
        const int row0 = u.pm * BM + wr * 64 + fr, col0 = u.pn * HALF + wc * 32 + 8 * fq; const float os = oscale * iscale;
#pragma unroll
        for (int ai = 0; ai < 2; ++ai)
#pragma unroll
            for (int m = 0; m < 4; ++m) { unsigned char* rowp = H + (size_t)(row0 + ai * HALF + m * 16) * ldh + col0;
                const f32x4 g0 = acc[ai][0][m][0] * iscale, g1 = acc[ai][0][m][1] * iscale, u0 = acc[ai][1][m][0] * os, u1 = acc[ai][1][m][1] * os;
                u32x2 w; w.x = pk4_fp8(silu_f(g0[0]) * u0[0], silu_f(g0[1]) * u0[1], silu_f(g0[2]) * u0[2], silu_f(g0[3]) * u0[3]);
                w.y = pk4_fp8(silu_f(g1[0]) * u1[0], silu_f(g1[1]) * u1[1], silu_f(g1[2]) * u1[2], silu_f(g1[3]) * u1[3]);
                *(u32x2*)rowp = w; }
    }
};
struct EpiSwiGLU8T {
    static constexpr bool PERM = true; static constexpr int NSTORE = 8;
    unsigned char* H; int nkt; float k1, cinv;
    static __device__ __forceinline__ f32x4 f(const f32x4 ag, const f32x4 au, const float k, const float ci) {
        const f32x4 e = ag * k; f32x4 t; t[0] = __builtin_amdgcn_exp2f(e[0]); t[1] = __builtin_amdgcn_exp2f(e[1]); t[2] = __builtin_amdgcn_exp2f(e[2]); t[3] = __builtin_amdgcn_exp2f(e[3]);
        const f32x4 d = t * ci + ci; f32x4 r; r[0] = __builtin_amdgcn_rcpf(d[0]); r[1] = __builtin_amdgcn_rcpf(d[1]); r[2] = __builtin_amdgcn_rcpf(d[2]); r[3] = __builtin_amdgcn_rcpf(d[3]);
        return (ag * au) * r;
    }
    __device__ __forceinline__ void operator()(const f32x4 (&acc)[2][2][4][2], const Unit& u, int wr, int wc, int fr, int fq) const {
        unsigned char* blk = H + ((size_t)u.pm * nkt + u.pn) * (size_t)(2 * HTB);
#pragma unroll
        for (int ai = 0; ai < 2; ++ai)
#pragma unroll
            for (int m = 0; m < 4; ++m) { unsigned char* rowp = blk + ai * HTB + lds_byte(wr * 64 + m * 16 + fr, wc * 16 + 4 * fq);
                const f32x4 o0 = f(acc[ai][0][m][0], acc[ai][1][m][0], k1, cinv), o1 = f(acc[ai][0][m][1], acc[ai][1][m][1], k1, cinv);
                u32x2 w; w.x = pk4_fp8(o0[0], o0[1], o0[2], o0[3]); w.y = pk4_fp8(o1[0], o1[1], o1[2], o1[3]);
                *(u32x2*)rowp = w; }
    }
};
struct EpiDown {
    static constexpr bool PERM = true; static constexpr int NSTORE = 16;
    bf16_t* Y; int ldc; const float* rowscale; float oscale;
    __device__ __forceinline__ void operator()(const f32x4 (&acc)[2][2][4][2], const Unit& u, int wr, int wc, int fr, int fq) const {
        const int row0 = u.pm * BM + wr * 64 + fr, col0 = u.pn * BM + wc * 32 + 8 * fq;
#pragma unroll
        for (int ai = 0; ai < 2; ++ai)
#pragma unroll
            for (int m = 0; m < 4; ++m) { const int row = row0 + ai * HALF + m * 16; const float g = rowscale[row] * oscale; bf16_t* rowp = Y + (size_t)row * ldc + col0;
#pragma unroll
                for (int bj = 0; bj < 2; ++bj) { const f32x4 v0 = acc[ai][bj][m][0] * g, v1 = acc[ai][bj][m][1] * g;
                    u32x4 w; w.x = cvt_pk_bf16(v0[0], v0[1]); w.y = cvt_pk_bf16(v0[2], v0[3]); w.z = cvt_pk_bf16(v1[0], v1[1]); w.w = cvt_pk_bf16(v1[2], v1[3]);
                    *(u32x4*)(rowp + bj * HALF) = w; } }
    }
};

template <class Epi, class Sched, bool F8 = false, bool SP2 = true, bool ALIGN_EPI = true, bool A_TILED = false, bool B_TILED = false, bool A_GATHER = false>
__device__ __forceinline__ void gemm_phase(PG8_LAS unsigned char* lds, const Gemm g, const Sched& S, const Epi& E) {
    int tid_ = threadIdx.x; asm volatile("" : "+v"(tid_));
    const int tid = tid_, wid = __builtin_amdgcn_readfirstlane(tid >> 6), lane = tid & 63, wr = wid >> 2, wc = wid & 3, fr = lane & 15, fq = lane >> 4;
    const int K = g.K, nt = K / BK;
    unsigned voffA[2], voffB[2];
#pragma unroll
    for (int i = 0; i < 2; ++i) { int R, C; stage_rc(tid * 16 + i * 8192, R, C); const int Rb = Epi::PERM ? ((R & ~31) + perm32(R & 31)) : R;
        voffA[i] = A_TILED ? (unsigned)(tid * 16 + i * 8192) : (unsigned)(R * K + C) * 2u; voffB[i] = B_TILED ? (unsigned)(tid * 16 + i * 8192) : (unsigned)(Rb * K + C) * 2u; }
    unsigned tadr[2], cg[2];
#pragma unroll
    for (int i = 0; i < 2; ++i) { int R, C; stage_rc(tid * 16 + i * 8192, R, C); tadr[i] = (unsigned)(g.tbl_off + R * 2); cg[i] = (unsigned)(C * 2); }
    const size_t kstepA = A_TILED ? (size_t)(2 * HTB) : (size_t)(BK * 2), kstepB = B_TILED ? (size_t)(2 * HTB) : (size_t)(BK * 2);
    const size_t hstepA = A_TILED ? (size_t)HTB : (size_t)HALF * K * 2, hstepB = B_TILED ? (size_t)HTB : (size_t)HALF * K * 2;
    const size_t tstep = (size_t)BM * K * 2;
    const unsigned ldsw = (unsigned)wid * 1024u;
    const int aoff = lds_byte(wr * 64 + fr, fq * 8), boff = lds_byte(wc * 32 + fr, fq * 8);
#define PG8_SA(b, h) (((b) * 2 + (h)) * HTB)
#define PG8_SB(b, h) ((4 + (b) * 2 + (h)) * HTB)
#define PG8_STAGE(bufoff, gbase, voff) do { _Pragma("unroll") for (int _i = 0; _i < 2; ++_i) \
        __builtin_amdgcn_global_load_lds((const unsigned*)((const char*)(gbase) + (voff)[_i]), (PG8_LAS unsigned*)(lds + (bufoff) + ldsw + _i * 8192), 16, 0, 0); } while (0)
#define PG8_STAGE_A(bufoff, ptrexpr, U, KT, H) do { if constexpr (A_GATHER) { _Pragma("unroll") for (int _i = 0; _i < 2; ++_i) { \
        const unsigned e_ = *(const PG8_LAS unsigned short*)(lds + tadr[_i] + (U) * 512 + (H) * 256); \
        __builtin_amdgcn_global_load_lds((const unsigned*)((const char*)g.A + (size_t)(KT) * (BK * 2) + (e_ * (unsigned)(K * 2) + cg[_i])), (PG8_LAS unsigned*)(lds + (bufoff) + ldsw + _i * 8192), 16, 0, 0); } } \
    else PG8_STAGE(bufoff, ptrexpr, voffA); } while (0)
#define PG8_LDA(dst, b, h) do { _Pragma("unroll") for (int m = 0; m < 4; ++m) _Pragma("unroll") for (int k = 0; k < 2; ++k) dst[m][k] = *(const PG8_LAS bf16x8*)(lds + PG8_SA(b, h) + aoff + m * 2048 + k * 1024); } while (0)
#define PG8_LDB(dst, b, h) do { _Pragma("unroll") for (int n = 0; n < 2; ++n) _Pragma("unroll") for (int k = 0; k < 2; ++k) dst[n][k] = *(const PG8_LAS bf16x8*)(lds + PG8_SB(b, h) + boff + n * 2048 + k * 1024); } while (0)
#define PG8_MMA(ai, bj, At, Bt) do { __builtin_amdgcn_s_setprio(1); _Pragma("unroll") for (int m = 0; m < 4; ++m) _Pragma("unroll") for (int n = 0; n < 2; ++n) { \
        if constexpr (F8) { const i32x8 b8_ = cat8(Bt[n][0], Bt[n][1]), a8_ = cat8(At[m][0], At[m][1]); asm volatile("v_mfma_f32_16x16x128_f8f6f4 %0, %1, %2, %0" : "+v"(acc[ai][bj][m][n]) : "v"(b8_), "v"(a8_)); } \
        else { _Pragma("unroll") for (int k = 0; k < 2; ++k) acc[ai][bj][m][n] = __builtin_amdgcn_mfma_f32_16x16x32_bf16(Bt[n][k], At[m][k], acc[ai][bj][m][n], 0, 0, 0); } } __builtin_amdgcn_s_setprio(0); } while (0)
#define PG8_WAIT_V(n) asm volatile("s_waitcnt vmcnt(" #n ")" ::: "memory")
#define PG8_WAIT_VF(f, n) asm volatile("s_cmp_eq_u32 %0, 0\n\ts_cbranch_scc0 1f\n\ts_waitcnt vmcnt(8)\n1:\n\ts_waitcnt vmcnt(%1)" :: "s"(f), "n"(n) : "memory", "scc")
#define PG8_WAIT_L(n) asm volatile("s_waitcnt lgkmcnt(" #n ")" ::: "memory")
#define PG8_BAR __builtin_amdgcn_s_barrier()
#define PG8_SCHED __builtin_amdgcn_sched_barrier(0)
    if constexpr (A_GATHER) {
        Unit u_; for (int i = tid >> 8; S.next(i, u_); i += 2) *(PG8_LAS unsigned short*)(lds + g.tbl_off + (i * 256 + (tid & 255)) * 2) = (unsigned short)g.ridx[u_.pm * BM + (tid & 255)];
        __syncthreads();
    }
    Unit cur, nxt; int ui = 0;
    if (!S.next(0, cur)) return;
    f32x4 acc[2][2][4][2];
#pragma unroll
    for (int a = 0; a < 2; ++a)
#pragma unroll
        for (int b = 0; b < 2; ++b)
#pragma unroll
            for (int m = 0; m < 4; ++m)
#pragma unroll
                for (int n = 0; n < 2; ++n) acc[a][b][m][n] = (f32x4){0.f, 0.f, 0.f, 0.f};
    bf16x8 At[4][2], B0[2][2], B1[2][2];
    const char* cA = (const char*)g.A + (size_t)cur.pm * tstep; const char* cB = (const char*)g.Bt + (size_t)cur.pb * tstep;
    if constexpr (SP2) {
        PG8_STAGE(PG8_SB(0, 0), cB, voffB); PG8_STAGE(PG8_SB(0, 1), cB + hstepB, voffB); PG8_STAGE_A(PG8_SA(0, 0), cA, 0, 0, 0); PG8_STAGE_A(PG8_SA(0, 1), cA + hstepA, 0, 0, 1);
        if (wr == 1) PG8_BAR;
        PG8_WAIT_V(2); PG8_BAR;
        PG8_STAGE(PG8_SB(1, 0), cB + kstepB, voffB); PG8_STAGE_A(PG8_SA(1, 0), cA + kstepA, 0, 1, 0); PG8_STAGE(PG8_SB(1, 1), cB + hstepB + kstepB, voffB);
        PG8_WAIT_V(6); PG8_BAR;
    } else {
    PG8_STAGE(PG8_SB(0, 0), cB, voffB); PG8_STAGE(PG8_SA(0, 0), cA, voffA); PG8_STAGE(PG8_SB(0, 1), cB + hstepB, voffB); PG8_STAGE(PG8_SA(0, 1), cA + hstepA, voffA);
    if (wr == 1) PG8_BAR;
    PG8_WAIT_V(4); PG8_BAR;
    PG8_STAGE(PG8_SB(1, 0), cB + kstepB, voffB); PG8_STAGE(PG8_SA(1, 0), cA + kstepA, voffA); PG8_STAGE(PG8_SB(1, 1), cB + hstepB + kstepB, voffB);
    PG8_WAIT_V(6); PG8_BAR;
    }
    for (;;) {
        const bool has_next = S.next(ui + 1, nxt);
        const char* nA = has_next ? (const char*)g.A + (size_t)nxt.pm * tstep : cA; const char* nB = has_next ? (const char*)g.Bt + (size_t)nxt.pb * tstep : cB;
        for (int t = 0; t < nt; t += 2) {
            const bool last = (t == nt - 2);
            const int fst = __builtin_amdgcn_readfirstlane(((t == 0) && ui > 0) ? 1 : 0);
            const char* a1 = cA + (size_t)(t + 1) * kstepA;
            const char* a2 = last ? nA : cA + (size_t)(t + 2) * kstepA; const char* b2 = last ? nB : cB + (size_t)(t + 2) * kstepB;
            const char* a3 = a2 + kstepA; const char* b3 = b2 + kstepB;
            const int u2 = last ? (has_next ? ui + 1 : ui) : ui, k2 = last ? 0 : t + 2;
            if constexpr (SP2) {
            PG8_LDB(B0, 0, 0); PG8_LDB(B1, 0, 1); PG8_SCHED; PG8_LDA(At, 0, 0); PG8_STAGE_A(PG8_SA(1, 1), a1 + hstepA, ui, t + 1, 1);
            PG8_WAIT_VF(fst, 8 + Epi::NSTORE);
            PG8_WAIT_L(0); PG8_BAR; PG8_MMA(0, 0, At, B0); PG8_MMA(0, 1, At, B1); PG8_BAR; PG8_SCHED;
            PG8_LDA(At, 0, 1); PG8_STAGE(PG8_SB(0, 0), b2, voffB); PG8_STAGE(PG8_SB(0, 1), b2 + hstepB, voffB); PG8_STAGE_A(PG8_SA(0, 0), a2, u2, k2, 0);
            PG8_WAIT_VF(fst, 8 + Epi::NSTORE);
            PG8_WAIT_L(0); PG8_BAR; PG8_MMA(1, 0, At, B0); PG8_MMA(1, 1, At, B1); PG8_BAR; PG8_SCHED;
            PG8_LDB(B0, 1, 0); PG8_LDB(B1, 1, 1); PG8_SCHED; PG8_LDA(At, 1, 0); PG8_STAGE_A(PG8_SA(0, 1), a2 + hstepA, u2, k2, 1);
            PG8_WAIT_V(8); PG8_WAIT_L(0); PG8_BAR; PG8_MMA(0, 0, At, B0); PG8_MMA(0, 1, At, B1); PG8_BAR; PG8_SCHED;
            PG8_LDA(At, 1, 1); PG8_STAGE(PG8_SB(1, 0), b3, voffB); PG8_STAGE(PG8_SB(1, 1), b3 + hstepB, voffB); PG8_STAGE_A(PG8_SA(1, 0), a3, u2, k2 + 1, 0);
            PG8_WAIT_V(8); PG8_WAIT_L(0); PG8_BAR; PG8_MMA(1, 0, At, B0); PG8_MMA(1, 1, At, B1); PG8_BAR; PG8_SCHED;
            } else {
            PG8_LDB(B0, 0, 0); PG8_SCHED; PG8_LDA(At, 0, 0); PG8_STAGE(PG8_SA(1, 1), a1 + hstepA, voffA);
            PG8_WAIT_L(8); PG8_BAR; PG8_WAIT_L(0); PG8_MMA(0, 0, At, B0); PG8_BAR; PG8_SCHED;
            PG8_LDB(B1, 0, 1); PG8_STAGE(PG8_SB(0, 0), b2, voffB);
            PG8_BAR; PG8_WAIT_L(0); PG8_MMA(0, 1, At, B1); PG8_BAR;
            PG8_LDA(At, 0, 1); PG8_STAGE(PG8_SA(0, 0), a2, voffA);
            PG8_BAR; PG8_WAIT_L(0); PG8_MMA(1, 0, At, B0); PG8_BAR; PG8_SCHED;
            PG8_STAGE(PG8_SB(0, 1), b2 + hstepB, voffB);
            PG8_WAIT_V(6); PG8_BAR; PG8_MMA(1, 1, At, B1); PG8_BAR;
            PG8_LDB(B0, 1, 0); PG8_SCHED; PG8_LDA(At, 1, 0); PG8_STAGE(PG8_SA(0, 1), a2 + hstepA, voffA);
            PG8_WAIT_L(8); PG8_BAR; PG8_WAIT_L(0); PG8_MMA(0, 0, At, B0); PG8_BAR; PG8_SCHED;
            PG8_LDB(B1, 1, 1); PG8_STAGE(PG8_SB(1, 0), b3, voffB);
            PG8_BAR; PG8_WAIT_L(0); PG8_MMA(0, 1, At, B1); PG8_BAR;
            PG8_LDA(At, 1, 1); PG8_STAGE(PG8_SA(1, 0), a3, voffA);
            PG8_BAR; PG8_WAIT_L(0); PG8_MMA(1, 0, At, B0); PG8_BAR; PG8_SCHED;
            PG8_STAGE(PG8_SB(1, 1), b3 + hstepB, voffB);
            PG8_WAIT_V(6); PG8_BAR; PG8_MMA(1, 1, At, B1); PG8_BAR;
            }
        }
        if constexpr (ALIGN_EPI) { if (wr == 0) PG8_BAR; }
        if constexpr (F8) asm volatile("s_nop 15\n\ts_nop 15" ::: "memory");
        E(acc, cur, wr, wc, fr, fq);
        if (!has_next) break;
#pragma unroll
        for (int a = 0; a < 2; ++a)
#pragma unroll
            for (int b = 0; b < 2; ++b)
#pragma unroll
                for (int m = 0; m < 4; ++m)
#pragma unroll
                    for (int n = 0; n < 2; ++n) acc[a][b][m][n] = (f32x4){0.f, 0.f, 0.f, 0.f};
        cur = nxt; cA = nA; cB = nB; ++ui;
        if constexpr (ALIGN_EPI) { if (wr == 1) PG8_BAR; }
    }
    PG8_WAIT_V(0);
    if constexpr (!ALIGN_EPI) { if (wr == 0) PG8_BAR; }
    PG8_BAR;
#undef PG8_SA
#undef PG8_SB
#undef PG8_STAGE
#undef PG8_STAGE_A
#undef PG8_LDA
#undef PG8_LDB
#undef PG8_MMA
#undef PG8_WAIT_V
#undef PG8_WAIT_VF
#undef PG8_WAIT_L
#undef PG8_BAR
#undef PG8_SCHED
}
}
#include <string.h>
constexpr int MK_THREADS = 512;
constexpr float W1_SCALE = 32.0f, W2_SCALE = 64.0f, H_SCALE = 8.0f, LOG2E = 1.4426950408889634f;
constexpr int LDS_BYTES = 163840;
constexpr int MISC_OFF = LDS_BYTES - 1024;
constexpr int TBL_OFF = 131072, TBL_UNITS = (MISC_OFF - TBL_OFF) / 512;
constexpr size_t WS_CTL_BYTES = 1u << 20;
constexpr int CW_BAR = 4096;
constexpr int CW_QUEUE = 16384;
typedef unsigned short bf16;
typedef unsigned v4u __attribute__((ext_vector_type(4)));
#define GAS __attribute__((address_space(1)))
#define LDS_WAIT() asm volatile("s_waitcnt lgkmcnt(0)" ::: "memory")

__device__ __forceinline__ unsigned pk2(float lo, float hi) { unsigned r; asm volatile("v_cvt_pk_bf16_f32 %0, %1, %2" : "=v"(r) : "v"(lo), "v"(hi)); return r; }
#define BFLO(w) __builtin_bit_cast(float, (w) << 16)
#define BFHI(w) __builtin_bit_cast(float, (w) & 0xffff0000u)
__device__ __forceinline__ float bf2f(unsigned short b) { return __builtin_bit_cast(float, (unsigned)b << 16); }

__device__ __forceinline__ void p0_transpose_item(const float* W, int K, int N, bf16* WT, int mode, LAS float* scr, int item, int lane) {
    const int nblk = N / 32, kb = item / nblk, nb = item % nblk, k0 = 64 * kb, n0 = 32 * nb;
    const int r0 = mode == 0 ? n0 : (n0 / 128) * 256 + (n0 % 128) + (mode == 2 ? 128 : 0);
#pragma unroll 8
    for (int i = 0; i < 32; ++i) { const int kk = 2 * i + (lane >> 5); scr[kk * 33 + (lane & 31)] = __builtin_nontemporal_load(W + (size_t)(k0 + kk) * N + n0 + (lane & 31)); }
    LDS_WAIT(); asm volatile("" ::: "memory");
    const int c = lane & 7;
#pragma unroll
    for (int j = 0; j < 4; ++j) { const int n = (lane >> 3) + 8 * j; const LAS float* s = scr + (8 * c) * 33 + n;
        v4u o; o.x = pk2(s[0 * 33], s[1 * 33]); o.y = pk2(s[2 * 33], s[3 * 33]); o.z = pk2(s[4 * 33], s[5 * 33]); o.w = pk2(s[6 * 33], s[7 * 33]);
        *(GAS v4u*)(WT + (size_t)(r0 + n) * K + k0 + 8 * c) = o; }
    LDS_WAIT(); asm volatile("" ::: "memory");
}
__device__ __forceinline__ void conv_block_f8(const float* W, size_t src_stride, int nmat, int K, int N, unsigned char* WT, size_t dst_stride, int mode, float scale, LAS unsigned char* lds, int G) {
    int t_ = threadIdx.x; asm volatile("" : "+v"(t_)); const int tid0 = t_, wave = __builtin_amdgcn_readfirstlane(tid0 >> 6);
    LAS float* scr = (LAS float*)lds;
    const int nkb = K / 256, nnb = N / 64, per = nkb * nnb, total = nmat * per;
    pg8::f32x4 v[8];
#define CB_SRC(it_) (W + (size_t)((it_) / per) * src_stride + (size_t)(256 * (((it_) % per) / nnb)) * N + 64 * (((it_) % per) % nnb))
#define CB_LOAD(it_) do { const float* s_ = CB_SRC(it_); const int ln_ = tid0 & 63; _Pragma("unroll") for (int i = 0; i < 8; ++i) v[i] = __builtin_nontemporal_load((const pg8::f32x4*)(s_ + (size_t)(wave * 32 + i * 4 + (ln_ >> 4)) * N + (ln_ & 15) * 4));        } while (0)
    if ((int)blockIdx.x < total) CB_LOAD((int)blockIdx.x);
    for (int it = blockIdx.x; it < total; it += G) {
        int lane = tid0 & 63; asm volatile("" : "+v"(lane));
        const int mm = it / per, r = it % per, kb = r / nnb, nb = r % nnb, k0 = 256 * kb, n0 = 64 * nb;
        unsigned char* dst = WT + (size_t)mm * dst_stride;
        const int r0 = mode == 0 ? n0 : (n0 / 128) * 256 + (n0 % 128) + (mode == 2 ? 128 : 0);
        __syncthreads();
#pragma unroll
        for (int i = 0; i < 8; ++i) { const int kk = wave * 32 + i * 4 + (lane >> 4), c4 = (lane & 15) * 4; LAS float* q = scr + kk * 65 + c4; q[0] = v[i][0] * scale; q[1] = v[i][1] * scale; q[2] = v[i][2] * scale; q[3] = v[i][3] * scale; }
        __syncthreads();
        if (it + G < total) CB_LOAD(it + G);
#pragma unroll
        for (int i = 0; i < 2; ++i) { const int blk = wave * 2 + i, rg = blk >> 2, ktl = (blk >> 1) & 1, ch = blk & 1, R16 = lane & 15, pc = lane >> 4;
            const int Rl = rg * 16 + R16, nl = (Rl & ~31) + pg8::perm32(Rl & 31), kc = ktl * 128 + ch * 64 + pc * 16; const LAS float* s = scr + kc * 65 + nl;
            v4u o; o.x = pg8::pk4_fp8(s[0 * 65], s[1 * 65], s[2 * 65], s[3 * 65]); o.y = pg8::pk4_fp8(s[4 * 65], s[5 * 65], s[6 * 65], s[7 * 65]);
            o.z = pg8::pk4_fp8(s[8 * 65], s[9 * 65], s[10 * 65], s[11 * 65]); o.w = pg8::pk4_fp8(s[12 * 65], s[13 * 65], s[14 * 65], s[15 * 65]);
            const int R = (r0 & 127) + Rl;
            *(GAS v4u*)(dst + ((size_t)(r0 >> 8) * (K >> 7) + (k0 >> 7) + ktl) * 32768 + ((r0 >> 7) & 1) * 16384 + ((R >> 4) * 2 + ch) * 1024 + (((R & 15) * 64 + pc * 16) ^ ((R & 8) ? 32 : 0))) = o; }
    }
#undef CB_SRC
#undef CB_LOAD
    __syncthreads();
}
__device__ __forceinline__ void conv_ffn_dyn(const OP& p, int l, unsigned* qctr, LAS unsigned char* lds, int lo_, int nitems_) {
    const int LO = __builtin_amdgcn_readfirstlane(lo_), NIT = LO + __builtin_amdgcn_readfirstlane(nitems_);
    typedef Dims d;
    int t_ = threadIdx.x; asm volatile("" : "+v"(t_)); const int tid0 = t_, wave = __builtin_amdgcn_readfirstlane(tid0 >> 6);
    LAS float* scr = (LAS float*)lds; LAS int* slot = (LAS int*)(lds + MISC_OFF + 512);
    constexpr int PERM_ = 176, J = d::E * PERM_, TOTAL = 3 * J;
    static_assert((d::D / 256) * (d::FF / 64) == PERM_ && (d::FF / 256) * (d::D / 64) == PERM_, "item count");
    pg8::f32x4 v[8];
#define CD_LOAD(it_) do { const int job_ = (it_) / J, loc_ = (it_) - job_ * J, mm_ = loc_ / PERM_, r_ = loc_ - mm_ * PERM_, nnb_ = job_ == 2 ? d::D / 64 : d::FF / 64, kb_ = r_ / nnb_, nb_ = r_ - kb_ * nnb_, N_ = job_ == 2 ? d::D : d::FF; \
        const float* s_ = (job_ == 0 ? p.w_gate : (job_ == 1 ? p.w_up : p.w_down)) + ((size_t)l * d::E + mm_) * ((size_t)d::D * d::FF) + (size_t)(256 * kb_) * N_ + 64 * nb_; const int ln_ = tid0 & 63; \
        _Pragma("unroll") for (int i = 0; i < 8; ++i) v[i] = __builtin_nontemporal_load((const pg8::f32x4*)(s_ + (size_t)(wave * 32 + i * 4 + (ln_ >> 4)) * N_ + (ln_ & 15) * 4)); } while (0)
    unsigned pend = 0u;
    if (tid0 == 0) { slot[0] = (int)__hip_atomic_fetch_add(qctr, 1u, __ATOMIC_RELAXED, __HIP_MEMORY_SCOPE_AGENT); pend = __hip_atomic_fetch_add(qctr, 1u, __ATOMIC_RELAXED, __HIP_MEMORY_SCOPE_AGENT); }
    __syncthreads();
    int sf_ = MISC_OFF + 512; asm volatile("" : "+v"(sf_));
    int cur = LO + __builtin_amdgcn_readfirstlane(*(LAS int*)(lds + sf_));
    if (cur < NIT) CD_LOAD(cur);
    for (int k = 0; cur < NIT; ++k) {
        int lane = tid0 & 63; asm volatile("" : "+v"(lane));
        const int job = cur / J, loc = cur - job * J, mm = loc / PERM_, r = loc - mm * PERM_, nnb = job == 2 ? d::D / 64 : d::FF / 64, kb = r / nnb, nb = r - kb * nnb, k0 = 256 * kb, n0 = 64 * nb;
        const int K = job == 2 ? d::FF : d::D; const float scale = job == 2 ? W2_SCALE : W1_SCALE;
        unsigned char* dst = (unsigned char*)(job == 2 ? p.ffnW2 : p.ffnW1) + (size_t)mm * (job == 2 ? (size_t)d::D * d::FF : (size_t)2 * d::FF * d::D);
        const int r0 = job == 2 ? n0 : (n0 / 128) * 256 + (n0 % 128) + (job == 1 ? 128 : 0);
        __syncthreads();
        if (tid0 == 0) { slot[0] = (int)pend; pend = __hip_atomic_fetch_add(qctr, 1u, __ATOMIC_RELAXED, __HIP_MEMORY_SCOPE_AGENT); }
#pragma unroll
        for (int i = 0; i < 8; ++i) { const int kk = wave * 32 + i * 4 + (lane >> 4), c4 = (lane & 15) * 4; LAS float* q = scr + kk * 65 + c4; q[0] = v[i][0] * scale; q[1] = v[i][1] * scale; q[2] = v[i][2] * scale; q[3] = v[i][3] * scale; }
        __syncthreads();
        int so_ = MISC_OFF + 512; asm volatile("" : "+v"(so_));
        const int nxt = LO + __builtin_amdgcn_readfirstlane(*(LAS int*)(lds + so_));
        if (nxt < NIT) CD_LOAD(nxt);
#pragma unroll
        for (int i = 0; i < 2; ++i) { const int blk = wave * 2 + i, rg = blk >> 2, ktl = (blk >> 1) & 1, ch = blk & 1, R16 = lane & 15, pc = lane >> 4;
            const int Rl = rg * 16 + R16, nl = (Rl & ~31) + pg8::perm32(Rl & 31), kc = ktl * 128 + ch * 64 + pc * 16; const LAS float* sp = scr + kc * 65 + nl;
            v4u o; o.x = pg8::pk4_fp8(sp[0 * 65], sp[1 * 65], sp[2 * 65], sp[3 * 65]); o.y = pg8::pk4_fp8(sp[4 * 65], sp[5 * 65], sp[6 * 65], sp[7 * 65]);
            o.z = pg8::pk4_fp8(sp[8 * 65], sp[9 * 65], sp[10 * 65], sp[11 * 65]); o.w = pg8::pk4_fp8(sp[12 * 65], sp[13 * 65], sp[14 * 65], sp[15 * 65]);
            const int R = (r0 & 127) + Rl;
            *(GAS v4u*)(dst + ((size_t)(r0 >> 8) * (K >> 7) + (k0 >> 7) + ktl) * 32768 + ((r0 >> 7) & 1) * 16384 + ((R >> 4) * 2 + ch) * 1024 + (((R & 15) * 64 + pc * 16) ^ ((R & 8) ? 32 : 0))) = o; }
        cur = nxt;
    }
#undef CD_LOAD
    __syncthreads();
}
__device__ __forceinline__ void conv_group(const float* W, size_t src_stride, int nmat, int K, int N, bf16* WT, size_t dst_stride, int mode, LAS float* scr, int gw, int ngw, int lane) {
    const int per = (K / 64) * (N / 32), total = nmat * per;
    for (int it = gw; it < total; it += ngw) { const int m = it / per, r = it % per; p0_transpose_item(W + (size_t)m * src_stride, K, N, WT + (size_t)m * dst_stride, mode, scr, r, lane); }
}

typedef float f32x4v __attribute__((ext_vector_type(4)));
typedef unsigned u32x2v __attribute__((ext_vector_type(2)));
__device__ __forceinline__ float wave_sum(float v) {
#pragma unroll
    for (int o = 1; o < 64; o <<= 1) v += __shfl_xor(v, o);
    return v;
}
__device__ __forceinline__ float fast_silu(float x) { return x * __builtin_amdgcn_rcpf(1.0f + __expf(-x)); }

__device__ __forceinline__ void phase_mod(const OP& p, LAS unsigned char* lds, int G) {
    typedef Dims d; constexpr int D6 = 6 * d::D, NS = d::B + 1, NU = d::DEPTH * (D6 / 64);
    int t_ = threadIdx.x; asm volatile("" : "+v"(t_)); const int tid = t_, lane = tid & 63, wave = __builtin_amdgcn_readfirstlane(tid >> 6);
    LAS float* sc = (LAS float*)lds;
    LAS float* red = (LAS float*)(lds + NS * d::D * 4);
    for (int i = tid; i < NS * d::D; i += MK_THREADS) { const int s = i / d::D, k = i % d::D; const float v = s < d::B ? p.c[(size_t)s * d::D + k] : p.c_ctx[k]; sc[i] = v / (1.0f + expf(-v)); }
    __syncthreads();
    for (int u = blockIdx.x; u < NU; u += G) {
        const int l = u / (D6 / 64), cb = u % (D6 / 64), col = cb * 64 + lane;
        const float* w = p.w_mod + (size_t)l * d::D * D6 + col;
        float acc[NS];
#pragma unroll
        for (int s = 0; s < NS; ++s) acc[s] = 0.f;
        const int k0 = wave * (d::D / 8);
        for (int kb = k0; kb < k0 + d::D / 8; kb += 16) {
            float wv[16];
#pragma unroll
            for (int i = 0; i < 16; ++i) wv[i] = __builtin_nontemporal_load(w + (size_t)(kb + i) * D6);
#pragma unroll
            for (int i = 0; i < 16; ++i) {
#pragma unroll
                for (int s = 0; s < NS; ++s) acc[s] += sc[s * d::D + kb + i] * wv[i]; } }
#pragma unroll
        for (int s = 0; s < NS; ++s) red[(wave * NS + s) * 64 + lane] = acc[s];
        __syncthreads();
        for (int i = tid; i < NS * 64; i += MK_THREADS) { const int s = i / 64, cl = i % 64; float v = 0.f;
#pragma unroll
            for (int wv = 0; wv < 8; ++wv) v += red[(wv * NS + s) * 64 + cl];
            p.mod[((size_t)l * NS + s) * D6 + cb * 64 + cl] = v + p.b_mod[(size_t)l * D6 + cb * 64 + cl]; }
        __syncthreads();
    }
}

template <int MODE>
__device__ __forceinline__ void phase_rows(const OP& p, LAS unsigned char* lds, int G, const float* src, const float* src2, int nrows, int lc, int ln, int which) {
    typedef Dims d;
    int t_ = threadIdx.x; asm volatile("" : "+v"(t_)); const int tid = t_, lane = tid & 63, wave = __builtin_amdgcn_readfirstlane(tid >> 6);
    LAS float* wr = (LAS float*)lds;
    if (MODE & 16) {
        const float* w = p.w_router + (size_t)ln * d::D * d::E;
        for (int i = tid; i < d::D * d::E; i += MK_THREADS) { const int k = i / d::E, e = i % d::E; wr[e * d::D + k] = w[i]; }
        __syncthreads();
    }
    const int gw = blockIdx.x * 8 + wave, ngw = G * 8, rpw = (nrows + ngw - 1) / ngw;
    const int rbeg = gw * rpw, rend = (rbeg + rpw < nrows) ? rbeg + rpw : nrows;
    if (rbeg >= rend) return;
#define ROW_PTR(r) ((r) < d::NL ? src + (size_t)(r) * d::D : src2 + (size_t)((r) - d::NL) * d::D)
    f32x4v xn[4];
#pragma unroll
    for (int j = 0; j < 4; ++j) xn[j] = *(const f32x4v*)(ROW_PTR(rbeg) + 4 * lane + 256 * j);
    int mcur = -1; f32x4v gv[4], sh[4], sc1[4], gt[4];
    for (int r = rbeg; r < rend; ++r) {
        const int mi = r < d::NL ? r / d::S : d::B;
        f32x4v x[4];
#pragma unroll
        for (int j = 0; j < 4; ++j) x[j] = xn[j];
        if (r + 1 < rend) {
#pragma unroll
            for (int j = 0; j < 4; ++j) xn[j] = *(const f32x4v*)(ROW_PTR(r + 1) + 4 * lane + 256 * j); }
        if (mi != mcur) {
            mcur = mi;
            if (MODE & 8) { const float* g = (which ? p.g_ffn : p.g_mix) + (size_t)ln * d::D + 4 * lane; const float* mm = p.mod + ((size_t)ln * (d::B + 1) + mi) * 6 * d::D + 4 * lane;
#pragma unroll
                for (int j = 0; j < 4; ++j) { gv[j] = *(const f32x4v*)(g + 256 * j); sh[j] = *(const f32x4v*)(mm + (which ? 3 : 0) * d::D + 256 * j); sc1[j] = *(const f32x4v*)(mm + (which ? 4 : 1) * d::D + 256 * j) + 1.0f; } }
            if (MODE & 1) { const float* gp = p.mod + ((size_t)lc * (d::B + 1) + mi) * 6 * d::D + 5 * d::D + 4 * lane;
#pragma unroll
                for (int j = 0; j < 4; ++j) gt[j] = *(const f32x4v*)(gp + 256 * j); }
        }
        if (MODE & 1) {
            f32x4v s[4];
#pragma unroll
            for (int j = 0; j < 4; ++j) s[j] = (f32x4v){0.f, 0.f, 0.f, 0.f};
            const int mysl = lane < d::E ? p.slotof[(size_t)r * d::E + lane] : -1;
            for (int e = 0; e < d::E; ++e) { const int sl = __builtin_amdgcn_readlane(mysl, e); if (sl < 0) continue;
                const bf16* yr = p.ybufb + (size_t)sl * d::D + 4 * lane;
#pragma unroll
                for (int j = 0; j < 4; ++j) { const u32x2v w2 = (MODE & 4) ? __builtin_nontemporal_load((const u32x2v*)(yr + 256 * j)) : *(const u32x2v*)(yr + 256 * j); s[j] += (f32x4v){BFLO(w2.x), BFHI(w2.x), BFLO(w2.y), BFHI(w2.y)}; } }
#pragma unroll
            for (int j = 0; j < 4; ++j) x[j] += gt[j] * s[j];
        }
        if (MODE & 2) {
#pragma unroll
            for (int j = 0; j < 4; ++j) *(f32x4v*)(p.xcur + (size_t)r * d::D + 4 * lane + 256 * j) = x[j]; }
        if (MODE & 4) { if (r < d::NL) {
#pragma unroll
            for (int j = 0; j < 4; ++j) __builtin_nontemporal_store(x[j], (f32x4v*)(p.out + (size_t)r * d::D + 4 * lane + 256 * j)); } }
        if (MODE & 8) {
            float ss = 0.f;
#pragma unroll
            for (int j = 0; j < 4; ++j) ss += (x[j].x * x[j].x + x[j].y * x[j].y) + (x[j].z * x[j].z + x[j].w * x[j].w);
            const float rs = 1.0f / sqrtf(wave_sum(ss) * (1.0f / d::D) + 1e-6f);
            f32x4v h[4];
#pragma unroll
            for (int j = 0; j < 4; ++j) { h[j] = x[j] * rs * gv[j] * sc1[j] + sh[j];
                if (MODE & 16) *(unsigned*)((unsigned char*)p.hbf + (size_t)r * d::D + 4 * lane + 256 * j) = pg8::pk4_fp8(h[j].x, h[j].y, h[j].z, h[j].w);
                else { u32x2v o; o.x = pk2(h[j].x, h[j].y); o.y = pk2(h[j].z, h[j].w); *(u32x2v*)(p.hbf + (size_t)r * d::D + 4 * lane + 256 * j) = o; } }
            if (MODE & 16) {
                float lg[16]; int wo = 4 * lane; asm volatile("" : "+v"(wo));
#pragma unroll
                for (int e = 0; e < 16; ++e) { float a = 0.f;
#pragma unroll
                    for (int j = 0; j < 4; ++j) { const f32x4v wv = *(const LAS f32x4v*)(wr + e * d::D + wo + 256 * j); a += (h[j].x * wv.x + h[j].y * wv.y) + (h[j].z * wv.z + h[j].w * wv.w); }
                    lg[e] = a; }
                float v8[8], v4[4], v2[2], v1;
                { const bool hi = (lane & 32) != 0;
#pragma unroll
                  for (int i = 0; i < 8; ++i) { const float mine = hi ? lg[8 + i] : lg[i], theirs = hi ? lg[i] : lg[8 + i]; v8[i] = mine + __shfl_xor(theirs, 32); } }
                { const bool hi = (lane & 16) != 0;
#pragma unroll
                  for (int i = 0; i < 4; ++i) { const float mine = hi ? v8[4 + i] : v8[i], theirs = hi ? v8[i] : v8[4 + i]; v4[i] = mine + __shfl_xor(theirs, 16); } }
                { const bool hi = (lane & 8) != 0;
#pragma unroll
                  for (int i = 0; i < 2; ++i) { const float mine = hi ? v4[2 + i] : v4[i], theirs = hi ? v4[i] : v4[2 + i]; v2[i] = mine + __shfl_xor(theirs, 8); } }
                { const bool hi = (lane & 4) != 0; const float mine = hi ? v2[1] : v2[0], theirs = hi ? v2[0] : v2[1]; v1 = mine + __shfl_xor(theirs, 4); }
                v1 += __shfl_xor(v1, 1); v1 += __shfl_xor(v1, 2);
                float mx = v1;
#pragma unroll
                for (int o = 4; o < 64; o <<= 1) mx = fmaxf(mx, __shfl_xor(mx, o));
                const float ev = expf(v1 - mx); float sum = ev;
#pragma unroll
                for (int o = 4; o < 64; o <<= 1) sum += __shfl_xor(sum, o);
                const int e = ((lane >> 5) & 1) * 8 + ((lane >> 4) & 1) * 4 + ((lane >> 3) & 1) * 2 + ((lane >> 2) & 1);
                if ((lane & 3) == 0) p.aff[(size_t)r * d::E + e] = ev / sum;
            }
        }
    }
#undef ROW_PTR
}

__device__ __forceinline__ void router_finish(const float (&lg)[16], int lane, float* affrow) {
    float v8[8], v4[4], v2[2], v1;
    { const bool hi = (lane & 32) != 0;
#pragma unroll
      for (int i = 0; i < 8; ++i) { const float mine = hi ? lg[8 + i] : lg[i], theirs = hi ? lg[i] : lg[8 + i]; v8[i] = mine + __shfl_xor(theirs, 32); } }
    { const bool hi = (lane & 16) != 0;
#pragma unroll
      for (int i = 0; i < 4; ++i) { const float mine = hi ? v8[4 + i] : v8[i], theirs = hi ? v8[i] : v8[4 + i]; v4[i] = mine + __shfl_xor(theirs, 16); } }
    { const bool hi = (lane & 8) != 0;
#pragma unroll
      for (int i = 0; i < 2; ++i) { const float mine = hi ? v4[2 + i] : v4[i], theirs = hi ? v4[i] : v4[2 + i]; v2[i] = mine + __shfl_xor(theirs, 8); } }
    { const bool hi = (lane & 4) != 0; const float mine = hi ? v2[1] : v2[0], theirs = hi ? v2[0] : v2[1]; v1 = mine + __shfl_xor(theirs, 4); }
    v1 += __shfl_xor(v1, 1); v1 += __shfl_xor(v1, 2);
    float mx = v1;
#pragma unroll
    for (int o = 4; o < 64; o <<= 1) mx = fmaxf(mx, __shfl_xor(mx, o));
    const float ev = expf(v1 - mx); float sum = ev;
#pragma unroll
    for (int o = 4; o < 64; o <<= 1) sum += __shfl_xor(sum, o);
    const int e = ((lane >> 5) & 1) * 8 + ((lane >> 4) & 1) * 4 + ((lane >> 3) & 1) * 2 + ((lane >> 2) & 1);
    if ((lane & 3) == 0) affrow[e] = ev / sum;
}
constexpr int RT_P = 1028;
constexpr int RT_WT = 0, RT_HB = 16 * RT_P * 4, RT_PART = 2 * 16 * RT_P * 4;
__device__ __forceinline__ void phase_router(const OP& p, LAS unsigned char* lds, int G, const float* src, const float* src2, int nrows, int ln) {
    typedef Dims d;
    int t_ = threadIdx.x; asm volatile("" : "+v"(t_)); const int tid = t_, lane = tid & 63, wave = __builtin_amdgcn_readfirstlane(tid >> 6);
    LAS float* wt = (LAS float*)(lds + RT_WT); LAS float* hb = (LAS float*)(lds + RT_HB); LAS float* part = (LAS float*)(lds + RT_PART);
    { const f32x4v* w4 = (const f32x4v*)(p.w_router + (size_t)ln * d::D * d::E); f32x4v wv[8];
#pragma unroll
      for (int q = 0; q < 8; ++q) wv[q] = w4[tid + MK_THREADS * q];
#pragma unroll
      for (int q = 0; q < 8; ++q) { const int i4 = tid + MK_THREADS * q, k = i4 >> 2, e0 = (i4 & 3) * 4; wt[(e0 + 0) * RT_P + k] = wv[q].x; wt[(e0 + 1) * RT_P + k] = wv[q].y; wt[(e0 + 2) * RT_P + k] = wv[q].z; wt[(e0 + 3) * RT_P + k] = wv[q].w; } }
    __syncthreads();
    const int nblk = nrows / 16;
#define ROW_PTR(r) ((r) < d::NL ? src + (size_t)(r) * d::D : src2 + (size_t)((r) - d::NL) * d::D)
    f32x4v xn[2][4];
    if ((int)blockIdx.x < nblk) {
#pragma unroll
        for (int q = 0; q < 2; ++q)
#pragma unroll
            for (int j = 0; j < 4; ++j) xn[q][j] = *(const f32x4v*)(ROW_PTR(16 * (int)blockIdx.x + 2 * wave + q) + 4 * lane + 256 * j); }
    int mcur = -1; f32x4v gs[4], sh[4];
    for (int bi = blockIdx.x; bi < nblk; bi += G) {
        int lo_ = lane; asm volatile("" : "+v"(lo_));
        const int r = 16 * bi + 2 * wave, mi = r < d::NL ? r / d::S : d::B;
        f32x4v x[2][4];
#pragma unroll
        for (int q = 0; q < 2; ++q)
#pragma unroll
            for (int j = 0; j < 4; ++j) x[q][j] = xn[q][j];
        if (bi + G < nblk) {
#pragma unroll
            for (int q = 0; q < 2; ++q)
#pragma unroll
                for (int j = 0; j < 4; ++j) xn[q][j] = *(const f32x4v*)(ROW_PTR(16 * (bi + G) + 2 * wave + q) + 4 * lo_ + 256 * j); }
        if (mi != mcur) {
            mcur = mi; const float* g = p.g_ffn + (size_t)ln * d::D + 4 * lo_; const float* mm = p.mod + ((size_t)ln * (d::B + 1) + mi) * 6 * d::D + 4 * lo_;
#pragma unroll
            for (int j = 0; j < 4; ++j) { gs[j] = *(const f32x4v*)(g + 256 * j) * (*(const f32x4v*)(mm + 4 * d::D + 256 * j) + 1.0f); sh[j] = *(const f32x4v*)(mm + 3 * d::D + 256 * j); } }
        {
            float ssA = 0.f, ssB = 0.f;
#pragma unroll
            for (int j = 0; j < 4; ++j) { ssA += (x[0][j].x * x[0][j].x + x[0][j].y * x[0][j].y) + (x[0][j].z * x[0][j].z + x[0][j].w * x[0][j].w);
                                          ssB += (x[1][j].x * x[1][j].x + x[1][j].y * x[1][j].y) + (x[1][j].z * x[1][j].z + x[1][j].w * x[1][j].w); }
            const float rsA = 1.0f / sqrtf(wave_sum(ssA) * (1.0f / d::D) + 1e-6f), rsB = 1.0f / sqrtf(wave_sum(ssB) * (1.0f / d::D) + 1e-6f);
#pragma unroll
            for (int j = 0; j < 4; ++j) { const f32x4v hA = x[0][j] * rsA * gs[j] + sh[j], hB = x[1][j] * rsB * gs[j] + sh[j];
                *(unsigned*)((unsigned char*)p.hbf + (size_t)r * d::D + 4 * lo_ + 256 * j) = pg8::pk4_fp8(hA.x, hA.y, hA.z, hA.w);
                *(unsigned*)((unsigned char*)p.hbf + (size_t)(r + 1) * d::D + 4 * lo_ + 256 * j) = pg8::pk4_fp8(hB.x, hB.y, hB.z, hB.w);
                *(LAS f32x4v*)(hb + (2 * wave) * RT_P + 4 * lo_ + 256 * j) = hA; *(LAS f32x4v*)(hb + (2 * wave + 1) * RT_P + 4 * lo_ + 256 * j) = hB; }
        }
        __syncthreads();
        {
            const LAS float* ap = hb + (lo_ & 15) * RT_P + 128 * wave + 32 * (lo_ >> 4); const LAS float* bp = wt + (lo_ & 15) * RT_P + 128 * wave + 32 * (lo_ >> 4);
            pg8::f32x4 acc = (pg8::f32x4){0.f, 0.f, 0.f, 0.f};
#pragma unroll
            for (int t4 = 0; t4 < 8; ++t4) { const f32x4v a4 = *(const LAS f32x4v*)(ap + 4 * t4), b4 = *(const LAS f32x4v*)(bp + 4 * t4);
                acc = __builtin_amdgcn_mfma_f32_16x16x4f32(a4.x, b4.x, acc, 0, 0, 0); acc = __builtin_amdgcn_mfma_f32_16x16x4f32(a4.y, b4.y, acc, 0, 0, 0);
                acc = __builtin_amdgcn_mfma_f32_16x16x4f32(a4.z, b4.z, acc, 0, 0, 0); acc = __builtin_amdgcn_mfma_f32_16x16x4f32(a4.w, b4.w, acc, 0, 0, 0); }
#pragma unroll
            for (int rr = 0; rr < 4; ++rr) part[wave * 256 + (4 * (lo_ >> 4) + rr) * 16 + (lo_ & 15)] = acc[rr];
        }
        __syncthreads();
        if (tid < 256) {
            float v = 0.f;
#pragma unroll
            for (int w8 = 0; w8 < 8; ++w8) v += part[w8 * 256 + tid];
            float mx = v;
#pragma unroll
            for (int o = 1; o < 16; o <<= 1) mx = fmaxf(mx, __shfl_xor(mx, o));
            const float ev = expf(v - mx); float sum = ev;
#pragma unroll
            for (int o = 1; o < 16; o <<= 1) sum += __shfl_xor(sum, o);
            p.aff[(size_t)(16 * bi) * d::E + tid] = ev / sum;
        }
    }
#undef ROW_PTR
    __syncthreads();
}

__device__ __forceinline__ void phase_topk(const OP& p, LAS unsigned char* lds, int G, bool with_ctx) {
    typedef Dims d;
    int t_ = threadIdx.x; asm volatile("" : "+v"(t_)); const int tid = t_, lane = tid & 63, wave = __builtin_amdgcn_readfirstlane(tid >> 6);
    LAS unsigned* keys = (LAS unsigned*)lds;
    LAS unsigned* hist = (LAS unsigned*)(lds + 8192);
    LAS int* sel = (LAS int*)(lds + 8192 + 1024);
    LAS unsigned* scal = (LAS unsigned*)(lds + 8192 + 2048);
    const int NU = d::B * d::E * (with_ctx ? 2 : 1);
    for (int u = blockIdx.x; u < NU; u += G) {
        const int kind = u >= d::B * d::E ? 1 : 0, ue = u % (d::B * d::E), e = ue / d::B, b = ue % d::B;
        const int L = kind ? d::C : d::S, cap = kind ? d::capC : d::capL, r0 = kind ? d::NL + b * d::C : b * d::S;
        __syncthreads();
        for (int t = tid; t < L; t += MK_THREADS) keys[t] = __builtin_bit_cast(unsigned, p.aff[(size_t)(r0 + t) * d::E + e]);
        __syncthreads();
        const bool valid = 4 * tid < L; unsigned k[4];
#pragma unroll
        for (int i = 0; i < 4; ++i) k[i] = valid ? keys[4 * tid + i] : 0u;
        unsigned prefix = 0u, remaining = (unsigned)cap;
        for (int pass = 0; pass < 4; ++pass) {
            const int shift = 24 - 8 * pass;
            if (tid < 256) hist[tid] = 0u;
            __syncthreads();
            if (valid) {
#pragma unroll
                for (int i = 0; i < 4; ++i) if (pass == 0 || (k[i] >> (shift + 8)) == (prefix >> (shift + 8))) __hip_atomic_fetch_add(&hist[(k[i] >> shift) & 255u], 1u, __ATOMIC_RELAXED, __HIP_MEMORY_SCOPE_WORKGROUP); }
            __syncthreads();
            if (wave == 0) {
                unsigned c4[4]; unsigned s = 0u;
#pragma unroll
                for (int j = 0; j < 4; ++j) { c4[j] = hist[4 * lane + j]; s += c4[j]; }
                unsigned incl = s;
#pragma unroll
                for (int o = 1; o < 64; o <<= 1) { const unsigned t = __shfl_down(incl, o); if (lane + o < 64) incl += t; }
                const unsigned excl = incl - s;
                if (excl < remaining && remaining <= incl) { unsigned cum = excl; int bin = 4 * lane; unsigned nr = remaining;
#pragma unroll
                    for (int j = 3; j >= 0; --j) { if (cum + c4[j] >= remaining) { bin = 4 * lane + j; nr = remaining - cum; break; } cum += c4[j]; }
                    scal[0] = (unsigned)bin; scal[1] = nr; }
            }
            __syncthreads();
            prefix |= scal[0] << shift; remaining = scal[1];
        }
        unsigned cnt = 0u;
#pragma unroll
        for (int i = 0; i < 4; ++i) if (valid) cnt += (k[i] > prefix ? 1u : 0u) + (k[i] == prefix ? 0x10000u : 0u);
        unsigned inc = cnt;
#pragma unroll
        for (int o = 1; o < 64; o <<= 1) { const unsigned t = __shfl_up(inc, o); if (lane >= o) inc += t; }
        if (lane == 63) scal[8 + wave] = inc;
        __syncthreads();
        unsigned base = inc - cnt;
        for (int w = 0; w < wave; ++w) base += scal[8 + w];
        unsigned gpos = base & 0xffffu, epos = base >> 16; const unsigned ngt = (unsigned)cap - remaining;
        const int slot0 = (kind ? d::NSL : 0) + (e * d::B + b) * cap;
        if (valid) {
#pragma unroll
            for (int i = 0; i < 4; ++i) { const int row = r0 + 4 * tid + i; int slot = -1;
                if (k[i] > prefix) { slot = slot0 + (int)gpos; ++gpos; }
                else if (k[i] == prefix) { if (epos < remaining) slot = slot0 + (int)(ngt + epos); ++epos; }
                p.slotof[(size_t)row * d::E + e] = slot;
                if (slot >= 0) { p.rowidx[slot] = row; p.gate[slot] = __builtin_bit_cast(float, k[i]); } }
        }
        __syncthreads();
    }
    __syncthreads();
}

typedef short bf16x8v __attribute__((ext_vector_type(8)));
typedef float f32x16v __attribute__((ext_vector_type(16)));
#define MFMA32(a, b, c) __builtin_amdgcn_mfma_f32_32x32x16_bf16((a), (b), (c), 0, 0, 0)
__device__ __forceinline__ unsigned cvtpk(float lo, float hi) { unsigned r; asm volatile("v_cvt_pk_bf16_f32 %0, %1, %2" : "=v"(r) : "v"(lo), "v"(hi)); return r; }
__device__ __forceinline__ float xhalf_max(float x) { float a = x, b = x; asm volatile("s_nop 1\n\tv_permlane32_swap_b32 %0, %1" : "+v"(a), "+v"(b)); return fmaxf(a, b); }
__device__ __forceinline__ float xhalf_sum(float x) { float a = x, b = x; asm volatile("s_nop 1\n\tv_permlane32_swap_b32 %0, %1" : "+v"(a), "+v"(b)); return a + b; }
__device__ __forceinline__ int crow32(int reg, int hh) { return (reg & 3) + 8 * (reg >> 2) + 4 * hh; }

struct PrepBufs {
    bf16 *qb, *kb;
    bf16 *vTl, *vTc;
    bf16 *rqb, *rkb;
    bf16 *rkTl, *rkTc, *rvTl, *rvTc;
    bf16 *hglu;
    bf16 *sprevT;
};

constexpr int PREP_LP = 144, PREP_WL = 64 * PREP_LP;
__device__ __forceinline__ void load64(const bf16* u, int r0, int c0, LAS unsigned char* wl, int lane, float (&v)[64]) {
    v4u t[8];
#pragma unroll
    for (int i = 0; i < 8; ++i) t[i] = *(const v4u*)(u + (size_t)(r0 + 8 * i + (lane >> 3)) * Dims::INC + c0 + (lane & 7) * 8);
#pragma unroll
    for (int i = 0; i < 8; ++i) *(LAS v4u*)(wl + (8 * i + (lane >> 3)) * PREP_LP + (lane & 7) * 16) = t[i];
#pragma unroll
    for (int i = 0; i < 8; ++i) { const v4u w = *(const LAS v4u*)(wl + lane * PREP_LP + i * 16);
        v[8 * i] = BFLO(w.x); v[8 * i + 1] = BFHI(w.x); v[8 * i + 2] = BFLO(w.y); v[8 * i + 3] = BFHI(w.y); v[8 * i + 4] = BFLO(w.z); v[8 * i + 5] = BFHI(w.z); v[8 * i + 6] = BFLO(w.w); v[8 * i + 7] = BFHI(w.w); }
}
__device__ __forceinline__ void store64_row(bf16* dst0, int pitch, LAS unsigned char* wl, int lane, const float (&v)[64]) {
#pragma unroll
    for (int i = 0; i < 8; ++i) { v4u o; o.x = cvtpk(v[8 * i], v[8 * i + 1]); o.y = cvtpk(v[8 * i + 2], v[8 * i + 3]); o.z = cvtpk(v[8 * i + 4], v[8 * i + 5]); o.w = cvtpk(v[8 * i + 6], v[8 * i + 7]); *(LAS v4u*)(wl + lane * PREP_LP + i * 16) = o; }
#pragma unroll
    for (int i = 0; i < 8; ++i) { const v4u w = *(const LAS v4u*)(wl + (8 * i + (lane >> 3)) * PREP_LP + (lane & 7) * 16); *(v4u*)(dst0 + (size_t)(8 * i + (lane >> 3)) * pitch + (lane & 7) * 8) = w; }
}
__device__ __forceinline__ void store64_T(bf16* dst, int pitch, const float (&v)[64]) {
#pragma unroll
    for (int dd = 0; dd < 64; dd += 2) { const unsigned w = pk2(v[dd], v[dd + 1]); dst[(size_t)dd * pitch] = (bf16)(w & 0xffffu); dst[(size_t)(dd + 1) * pitch] = (bf16)(w >> 16); }
}
__device__ __forceinline__ void fast_sincos(float x, float* sn, float* cs) { float r = x * 0.15915494309189535f; r = r - floorf(r); *sn = __builtin_amdgcn_sinf(r); *cs = __builtin_amdgcn_cosf(r); }
template <int ITEMS>
__device__ __forceinline__ void phase_prep(const OP& p, const PrepBufs& pb, LAS unsigned char* lds, int G, int l, bool last) {
    typedef Dims d; const bf16* ub = (const bf16*)p.u;
    int t_ = threadIdx.x; asm volatile("" : "+v"(t_)); const int tid = t_, lane = tid & 63, wave = __builtin_amdgcn_readfirstlane(tid >> 6);
    constexpr int NU = d::NR / 64; LAS unsigned char* wl = lds + wave * PREP_WL;
    for (int wi = blockIdx.x * 8 + wave; wi < NU * 28; wi += G * 8) {
        const int u = wi / 28, it = wi % 28;
        const int r0 = u * 64; const int kind = r0 >= d::NL ? 1 : 0;
        const int b = kind ? (r0 - d::NL) / d::C : r0 / d::S, t0 = kind ? (r0 - d::NL) % d::C : r0 % d::S, L = kind ? d::C : d::S;
        {
            int lo_ = lane; asm volatile("" : "+v"(lo_)); const int r = r0 + lo_, t = t0 + lo_;
            float v[64];
            if (it < 10) {
                if (!(ITEMS & 1)) continue;
                const bool isq = it < 8; const int hi = isq ? it : it - 8;
                if (kind == 1 && last && isq) continue;
                load64(ub, r0, (isq ? d::oAQ : d::oAK) + hi * 64, wl, lo_, v);
                const float* g = (isq ? p.q_norm_g : p.k_norm_g) + (size_t)l * 64;
                float ss = 0.f;
#pragma unroll
                for (int k = 0; k < 64; ++k) ss += v[k] * v[k];
                const float rs = 1.0f / sqrtf(ss * (1.0f / 64.0f) + 1e-6f);
#pragma unroll
                for (int k = 0; k < 64; ++k) v[k] = v[k] * rs * g[k];
                if (kind == 0) {
                    const float prow = (float)(t / d::GRID_W), pcol = (float)(t % d::GRID_W);
#pragma unroll
                    for (int j = 0; j < 16; ++j) { const float inv = exp2f(-(float)j * (13.287712379549449f / 16.0f));
                        float sn, cs; fast_sincos(prow * inv, &sn, &cs); { const float x1 = v[j], x2 = v[j + 16]; v[j] = x1 * cs - x2 * sn; v[j + 16] = x1 * sn + x2 * cs; }
                        fast_sincos(pcol * inv, &sn, &cs); { const float x1 = v[32 + j], x2 = v[48 + j]; v[32 + j] = x1 * cs - x2 * sn; v[48 + j] = x1 * sn + x2 * cs; } }
                }
                store64_row(isq ? pb.qb + (size_t)r0 * d::AW + hi * 64 : pb.kb + (size_t)r0 * d::KVW + hi * 64, isq ? d::AW : d::KVW, wl, lo_, v);
            } else if (it < 12) {
                if (!(ITEMS & 1)) continue;
                const int hi = it - 10; load64(ub, r0, d::oAV + hi * 64, wl, lo_, v);
                store64_T((kind ? pb.vTc + ((size_t)(b * d::KVH + hi) * 64) * d::C : pb.vTl + ((size_t)(b * d::KVH + hi) * 64) * d::S) + t, L, v);
            } else if (it < 20) {
                if (!(ITEMS & 2)) continue;
                const bool isq = it < 16; const int hi = isq ? it - 12 : it - 16;
                if (kind == 1 && last && isq) continue;
                load64(ub, r0, (isq ? d::oRQ : d::oRK) + hi * 64, wl, lo_, v);
                const float pos = (float)(kind ? t : d::C + t), sc = isq ? 1.0f : 0.125f;
#pragma unroll
                for (int j = 0; j < 32; ++j) { const float inv = exp2f(-(float)j * (13.287712379549449f / 32.0f)); float sn, cs; fast_sincos(pos * inv, &sn, &cs);
                    const float x1 = v[j], x2 = v[j + 32]; v[j] = (x1 * cs - x2 * sn) * sc; v[j + 32] = (x1 * sn + x2 * cs) * sc; }
                store64_row((isq ? pb.rqb : pb.rkb) + (size_t)r0 * d::RW + hi * 64, d::RW, wl, lo_, v);
                if (!isq) store64_T((kind ? pb.rkTc + ((size_t)(b * d::RH + hi) * 64) * d::C : pb.rkTl + ((size_t)(b * d::RH + hi) * 64) * d::S) + t, L, v);
            } else if (it < 24) {
                if (!(ITEMS & 2)) continue;
                const int hi = it - 20; load64(ub, r0, d::oRV + hi * 64, wl, lo_, v);
                store64_T((kind ? pb.rvTc + ((size_t)(b * d::RH + hi) * 64) * d::C : pb.rvTl + ((size_t)(b * d::RH + hi) * 64) * d::S) + t, L, v);
            } else {
                if (!(ITEMS & 4)) continue;
                if (kind == 1 && last) continue;
                const int c0 = (it - 24) * 64;
#pragma unroll
                for (int i = 0; i < 8; ++i) { const size_t row = (size_t)(r0 + 8 * i + (lo_ >> 3)); const int cc = c0 + (lo_ & 7) * 8;
                    const v4u a = *(const v4u*)(ub + row * d::INC + d::oCV + cc), g4 = *(const v4u*)(ub + row * d::INC + d::oCV + d::CW + cc); v4u o;
#define GLU_(av, gv) ((av) * __builtin_amdgcn_rcpf(1.0f + __expf(-(gv))))
                    o.x = cvtpk(GLU_(BFLO(a.x), BFLO(g4.x)), GLU_(BFHI(a.x), BFHI(g4.x))); o.y = cvtpk(GLU_(BFLO(a.y), BFLO(g4.y)), GLU_(BFHI(a.y), BFHI(g4.y)));
                    o.z = cvtpk(GLU_(BFLO(a.z), BFLO(g4.z)), GLU_(BFHI(a.z), BFHI(g4.z))); o.w = cvtpk(GLU_(BFLO(a.w), BFLO(g4.w)), GLU_(BFHI(a.w), BFHI(g4.w)));
#undef GLU_
                    *(v4u*)(pb.hglu + row * d::CW + cc) = o; }
            }
        }
    }
}

constexpr int ATT_KP = 144, ATT_VP = 272;
constexpr int ATT_K_BYTES = 128 * ATT_KP, ATT_V_BYTES = 64 * ATT_VP;
__device__ __forceinline__ void att_unit(const OP& p, const PrepBufs& pb, LAS unsigned char* lds, int l, int kind, int b, int qblk, int kvh, int tid_, int lane_, int wave) {
    typedef Dims d;
    int tid = tid_; asm volatile("" : "+v"(tid)); const int lane = tid & 63;
    LAS unsigned char* Kt = lds; LAS unsigned char* Vt = lds + ATT_K_BYTES;
    const int g = wave >> 1, qh = wave & 1, h = kvh * d::G + g, q31 = lane & 31, hh = lane >> 5;
    const int rowq0 = (kind ? d::NL + b * d::C : b * d::S) + qblk * 128 + qh * 64;
    constexpr float SC = 0.125f * 1.4426950408889634f;
    bf16x8v qf[2][4];
#pragma unroll
    for (int qt = 0; qt < 2; ++qt)
#pragma unroll
        for (int ks = 0; ks < 4; ++ks) { const v4u w = *(const v4u*)(pb.qb + (size_t)(rowq0 + qt * 32 + q31) * d::AW + h * 64 + 16 * ks + 8 * hh); v4u o;
            o.x = cvtpk(BFLO(w.x) * SC, BFHI(w.x) * SC); o.y = cvtpk(BFLO(w.y) * SC, BFHI(w.y) * SC); o.z = cvtpk(BFLO(w.z) * SC, BFHI(w.z) * SC); o.w = cvtpk(BFLO(w.w) * SC, BFHI(w.w) * SC);
            qf[qt][ks] = __builtin_bit_cast(bf16x8v, o); }
    f32x16v O[2][2]; float m[2], lsum[2];
    const float sink2 = p.att_sink[(size_t)l * d::AH + h] * 1.4426950408889634f;
#pragma unroll
    for (int qt = 0; qt < 2; ++qt) { m[qt] = sink2; lsum[qt] = 1.0f;
#pragma unroll
        for (int dt = 0; dt < 2; ++dt)
#pragma unroll
            for (int i = 0; i < 16; ++i) O[qt][dt][i] = 0.f; }
    const int ngrp = kind ? 2 : 5;
#define AT_VALID(gi_) (!(kind == 0 && (gi_) < 3 && (qblk - 1 + (gi_) < 0 || qblk - 1 + (gi_) >= d::S / 128)))
#define AT_LOADG(gi_) do { int krow0_; const bf16* vsrc_; int voff_; \
        if (kind == 0 && (gi_) < 3) { const int kb_ = qblk - 1 + (gi_); krow0_ = b * d::S + kb_ * 128; vsrc_ = pb.vTl + ((size_t)(b * d::KVH + kvh) * 64) * d::S + kb_ * 128; voff_ = d::S; } \
        else { const int cg_ = kind ? (gi_) : (gi_) - 3; krow0_ = d::NL + b * d::C + cg_ * 128; vsrc_ = pb.vTc + ((size_t)(b * d::KVH + kvh) * 64) * d::C + cg_ * 128; voff_ = d::C; } \
        _Pragma("unroll") for (int i = 0; i < 2; ++i) { const int c = tid + MK_THREADS * i; \
            pk_[i] = *(const v4u*)(pb.kb + (size_t)(krow0_ + (c >> 3)) * d::KVW + kvh * 64 + (c & 7) * 8); pv_[i] = *(const v4u*)(vsrc_ + (size_t)(c >> 4) * voff_ + (c & 15) * 8); } } while (0)
    v4u pk_[2], pv_[2];
    int gnext = 0; while (gnext < ngrp && !AT_VALID(gnext)) ++gnext;
    if (gnext < ngrp) AT_LOADG(gnext);
    while (gnext < ngrp) {
        const int gi = gnext; const int mtype = (kind == 0 && gi == 0) ? 1 : ((kind == 0 && gi == 2) ? 2 : 0);
        __syncthreads();
#pragma unroll
        for (int i = 0; i < 2; ++i) { const int c = tid + MK_THREADS * i; *(LAS v4u*)(Kt + (c >> 3) * ATT_KP + (c & 7) * 16) = pk_[i]; *(LAS v4u*)(Vt + (c >> 4) * ATT_VP + (c & 15) * 16) = pv_[i]; }
        __syncthreads();
        ++gnext; while (gnext < ngrp && !AT_VALID(gnext)) ++gnext;
        if (gnext < ngrp) AT_LOADG(gnext);
        for (int kt = 0; kt < 4; ++kt) {
            bf16x8v kf[4];
#pragma unroll
            for (int ks = 0; ks < 4; ++ks) kf[ks] = *(const LAS bf16x8v*)(Kt + (kt * 32 + q31) * ATT_KP + (16 * ks + 8 * hh) * 2);
#pragma unroll
            for (int qt = 0; qt < 2; ++qt) {
                const int tq = 2 * qh + qt;
                if (mtype == 1 && kt < tq) continue;
                if (mtype == 2 && kt > tq) continue;
                f32x16v s;
#pragma unroll
                for (int i = 0; i < 16; ++i) s[i] = 0.f;
#pragma unroll
                for (int ks = 0; ks < 4; ++ks) s = MFMA32(kf[ks], qf[qt][ks], s);
                const int qq = tq * 32 + q31; float tmax = -3.0e38f;
#pragma unroll
                for (int i = 0; i < 16; ++i) tmax = fmaxf(tmax, s[i]);
                if (mtype != 0 && kt == tq) {
                    tmax = -3.0e38f;
#pragma unroll
                    for (int i = 0; i < 16; ++i) { const int kk = kt * 32 + crow32(i, hh); float x = s[i];
                        if (mtype == 1 ? kk < qq : kk > qq) x = -1.0e30f;
                        s[i] = x; tmax = fmaxf(tmax, x); } }
                tmax = xhalf_max(tmax);
                if (!__all(tmax <= m[qt])) {
                    const float mn = fmaxf(m[qt], tmax), corr = __builtin_amdgcn_exp2f(m[qt] - mn); m[qt] = mn; lsum[qt] *= corr;
#pragma unroll
                    for (int dt = 0; dt < 2; ++dt)
#pragma unroll
                        for (int i = 0; i < 16; ++i) O[qt][dt][i] *= corr; }
                const float mn = m[qt]; float ps = 0.f;
#pragma unroll
                for (int i = 0; i < 16; ++i) { s[i] = __builtin_amdgcn_exp2f(s[i] - mn); ps += s[i]; }
                ps = xhalf_sum(ps);
                lsum[qt] += ps;
#pragma unroll
                for (int st = 0; st < 2; ++st) {
                    v4u pk; pk.x = cvtpk(s[8 * st], s[8 * st + 1]); pk.y = cvtpk(s[8 * st + 2], s[8 * st + 3]); pk.z = cvtpk(s[8 * st + 4], s[8 * st + 5]); pk.w = cvtpk(s[8 * st + 6], s[8 * st + 7]);
                    const bf16x8v pf = __builtin_bit_cast(bf16x8v, pk);
#pragma unroll
                    for (int dt = 0; dt < 2; ++dt) {
                        const LAS unsigned char* vr = Vt + (32 * dt + q31) * ATT_VP + (kt * 32 + 16 * st + 4 * hh) * 2;
                        const u32x2v v0 = *(const LAS u32x2v*)vr, v1 = *(const LAS u32x2v*)(vr + 16);
                        v4u vv; vv.x = v0.x; vv.y = v0.y; vv.z = v1.x; vv.w = v1.y;
                        O[qt][dt] = MFMA32(__builtin_bit_cast(bf16x8v, vv), pf, O[qt][dt]);
                    }
                }
            }
        }
    }
#undef AT_VALID
#undef AT_LOADG
#pragma unroll
    for (int qt = 0; qt < 2; ++qt) { const float il = 1.0f / lsum[qt]; bf16* orow = p.mixbf + (size_t)(rowq0 + qt * 32 + q31) * d::D + h * 64;
#pragma unroll
        for (int dt = 0; dt < 2; ++dt)
#pragma unroll
            for (int rg = 0; rg < 4; ++rg) { u32x2v o; o.x = cvtpk(O[qt][dt][4 * rg] * il, O[qt][dt][4 * rg + 1] * il); o.y = cvtpk(O[qt][dt][4 * rg + 2] * il, O[qt][dt][4 * rg + 3] * il);
                *(u32x2v*)(orow + 32 * dt + 8 * rg + 4 * hh) = o; } }
}

__device__ __forceinline__ float ret_lg2(const OP& p, int l, int dir, int head) {
    const float z = p.ret_decay_logit[((size_t)l * 2 + dir) * Dims::RH + head]; return -log1pf(expf(-z)) * 1.4426950408889634f;
}
__device__ __forceinline__ bf16x8v scale_frag(const bf16x8v a, const float (&f)[8]) {
    const v4u w = __builtin_bit_cast(v4u, a); v4u o;
    o.x = cvtpk(__builtin_bit_cast(float, w.x << 16) * f[0], __builtin_bit_cast(float, w.x & 0xffff0000u) * f[1]);
    o.y = cvtpk(__builtin_bit_cast(float, w.y << 16) * f[2], __builtin_bit_cast(float, w.y & 0xffff0000u) * f[3]);
    o.z = cvtpk(__builtin_bit_cast(float, w.z << 16) * f[4], __builtin_bit_cast(float, w.z & 0xffff0000u) * f[5]);
    o.w = cvtpk(__builtin_bit_cast(float, w.w << 16) * f[6], __builtin_bit_cast(float, w.w & 0xffff0000u) * f[7]);
    return __builtin_bit_cast(bf16x8v, o);
}
__device__ __forceinline__ void ret_state_unit(const OP& p, const PrepBufs& pb, int l, int b, int head, int lane_, int wave) {
    typedef Dims d;
    int lane = lane_; asm volatile("" : "+v"(lane));
    const int dir = wave >> 2, dtile = (wave >> 1) & 1, etile = wave & 1, r31 = lane & 31, hh = lane >> 5;
    const float lg2 = ret_lg2(p, l, dir, head), cdec = exp2f(128.0f * lg2);
    f32x16v acc;
#pragma unroll
    for (int i = 0; i < 16; ++i) acc[i] = 0.f;
    const bf16* kTl = pb.rkTl + ((size_t)(b * d::RH + head) * 64 + 32 * dtile + r31) * d::S + 8 * hh; const bf16* kTc = pb.rkTc + ((size_t)(b * d::RH + head) * 64 + 32 * dtile + r31) * d::C + 8 * hh;
    const bf16* vTl = pb.rvTl + ((size_t)(b * d::RH + head) * 64 + 32 * etile + r31) * d::S + 8 * hh; const bf16* vTc = pb.rvTc + ((size_t)(b * d::RH + head) * 64 + 32 * etile + r31) * d::C + 8 * hh;
#define RS_GC(si) (dir == 0 ? (si) : ((si) < d::NCc ? d::NCc - 1 - (si) : d::NCc + (d::NCl - 1 - ((si) - d::NCc))))
#define RS_LOAD(A, B, gcv) do { const int _k = (gcv) < d::NCc ? 1 : 0, _pc = _k ? (gcv) : (gcv) - d::NCc; const bf16* _ka = (_k ? kTc : kTl) + _pc * 128; const bf16* _va = (_k ? vTc : vTl) + _pc * 128; \
        _Pragma("unroll") for (int ks = 0; ks < 8; ++ks) { A[ks] = *(const bf16x8v*)(_ka + 16 * ks); B[ks] = *(const bf16x8v*)(_va + 16 * ks); } } while (0)
    bf16x8v af[8], bfr[8], an[8], bn[8];
    RS_LOAD(af, bfr, RS_GC(0));
    for (int sidx = 0; sidx < d::NCH; ++sidx) {
        const int gc = RS_GC(sidx);
        if (sidx + 1 < d::NCH) RS_LOAD(an, bn, RS_GC(sidx + 1));
        bf16* sp = pb.sprevT + ((((size_t)(b * 2 + dir) * d::NCH + gc) * d::RH + head) * 64 + (32 * etile + r31)) * 64 + 32 * dtile;
#pragma unroll
        for (int rg = 0; rg < 4; ++rg) { u32x2v o; o.x = cvtpk(acc[4 * rg], acc[4 * rg + 1]); o.y = cvtpk(acc[4 * rg + 2], acc[4 * rg + 3]); *(u32x2v*)(sp + 8 * rg + 4 * hh) = o; }
#pragma unroll
        for (int i = 0; i < 16; ++i) acc[i] *= cdec;
        int hho = hh; asm volatile("" : "+v"(hho));
        const float e0 = lg2 * (float)(dir == 0 ? 127 - 8 * hho : 8 * hho), st1 = dir == 0 ? -lg2 : lg2;
#pragma unroll
        for (int ks = 0; ks < 8; ++ks) { float f[8];
#pragma unroll
            for (int jj = 0; jj < 8; ++jj) f[jj] = __builtin_amdgcn_exp2f(e0 + st1 * (float)(16 * ks + jj));
            acc = MFMA32(scale_frag(af[ks], f), bfr[ks], acc); }
#pragma unroll
        for (int ks = 0; ks < 8; ++ks) { af[ks] = an[ks]; bfr[ks] = bn[ks]; }
    }
#undef RS_GC
#undef RS_LOAD
}
constexpr int RO_KP = 144, RO_VP = 272, RO_K = 0, RO_V = 128 * RO_KP, RO_SF = RO_V + 64 * RO_VP, RO_SB = RO_SF + 64 * RO_KP, RO_SUB = RO_SB + 64 * RO_KP;
__device__ __forceinline__ void phase_retout(const OP& p, const PrepBufs& pb, LAS unsigned char* lds, int G, int l, bool last) {
    typedef Dims d;
    int t_ = threadIdx.x; asm volatile("" : "+v"(t_)); const int tid = t_, lane = tid & 63, wave = __builtin_amdgcn_readfirstlane(tid >> 6);
    const int sub = wave >> 2, qt = wave & 3;
    LAS unsigned char* base = lds + sub * RO_SUB;
    const int nch = last ? d::NCl : d::NCH, NU2 = d::B * nch * d::RH / 2;
    for (int u2 = blockIdx.x; u2 < NU2; u2 += G) {
        int tq_ = tid; asm volatile("" : "+v"(tq_)); const int t4 = tq_ & 255, r31 = tq_ & 31, hh = (tq_ >> 5) & 1;
        const int u = 2 * u2 + sub, head = u % d::RH, cidx = (u / d::RH) % nch, b = u / (d::RH * nch), gc = last ? cidx + d::NCc : cidx;
        const int kind = gc < d::NCc ? 1 : 0, pc = kind ? gc : gc - d::NCc, L = kind ? d::C : d::S, row0 = (kind ? d::NL + b * d::C : b * d::S) + pc * 128;
        __syncthreads();
#pragma unroll
        for (int i = 0; i < 4; ++i) { const int c = t4 + 256 * i;
            { const int key = c >> 3, part = c & 7; *(LAS v4u*)(base + RO_K + key * RO_KP + part * 16) = *(const v4u*)(pb.rkb + (size_t)(row0 + key) * d::RW + head * 64 + part * 8); }
            { const int e = c >> 4, part = c & 15; const bf16* vT = (kind ? pb.rvTc + ((size_t)(b * d::RH + head) * 64) * d::C : pb.rvTl + ((size_t)(b * d::RH + head) * 64) * d::S);
              *(LAS v4u*)(base + RO_V + e * RO_VP + part * 16) = *(const v4u*)(vT + (size_t)e * L + pc * 128 + part * 8); } }
#pragma unroll
        for (int i = 0; i < 2; ++i) { const int c = t4 + 256 * i, e = c >> 3, part = c & 7;
            *(LAS v4u*)(base + RO_SF + e * RO_KP + part * 16) = *(const v4u*)(pb.sprevT + ((((size_t)(b * 2 + 0) * d::NCH + gc) * d::RH + head) * 64 + e) * 64 + part * 8);
            *(LAS v4u*)(base + RO_SB + e * RO_KP + part * 16) = *(const v4u*)(pb.sprevT + ((((size_t)(b * 2 + 1) * d::NCH + gc) * d::RH + head) * 64 + e) * 64 + part * 8); }
        const int irow = qt * 32 + r31, row = row0 + irow;
        bf16x8v qf[4];
#pragma unroll
        for (int ks = 0; ks < 4; ++ks) qf[ks] = *(const bf16x8v*)(pb.rqb + (size_t)row * d::RW + head * 64 + 16 * ks + 8 * hh);
        const float lgf = ret_lg2(p, l, 0, head), lgb = ret_lg2(p, l, 1, head);
        float cf16[16], cb16[16];
#pragma unroll
        for (int i = 0; i < 16; ++i) { const float cr = (float)((i & 3) + 8 * (i >> 2)); cf16[i] = __builtin_amdgcn_exp2f(-lgf * cr); cb16[i] = __builtin_amdgcn_exp2f(lgb * cr); }
        __syncthreads();
        f32x16v o[2];
        {
            const float cf = exp2f(lgf * (float)(irow + 1)), cb = exp2f(lgb * (float)(128 - irow));
#pragma unroll
            for (int dt = 0; dt < 2; ++dt) { f32x16v af, ab;
#pragma unroll
                for (int i = 0; i < 16; ++i) { af[i] = 0.f; ab[i] = 0.f; }
#pragma unroll
                for (int ks = 0; ks < 4; ++ks) {
                    af = MFMA32(*(const LAS bf16x8v*)(base + RO_SF + (32 * dt + r31) * RO_KP + (16 * ks + 8 * hh) * 2), qf[ks], af);
                    ab = MFMA32(*(const LAS bf16x8v*)(base + RO_SB + (32 * dt + r31) * RO_KP + (16 * ks + 8 * hh) * 2), qf[ks], ab); }
#pragma unroll
                for (int i = 0; i < 16; ++i) o[dt][i] = af[i] * cf + ab[i] * cb; }
        }
        for (int kt = 0; kt < 4; ++kt) {
            f32x16v s;
#pragma unroll
            for (int i = 0; i < 16; ++i) s[i] = 0.f;
#pragma unroll
            for (int ks = 0; ks < 4; ++ks) s = MFMA32(*(const LAS bf16x8v*)(base + RO_K + (kt * 32 + r31) * RO_KP + (16 * ks + 8 * hh) * 2), qf[ks], s);
            const int dbase = irow - (kt * 32 + 4 * hh);
            if (kt < qt) { const float tf = __builtin_amdgcn_exp2f(lgf * (float)dbase);
#pragma unroll
                for (int i = 0; i < 16; ++i) s[i] *= tf * cf16[i]; }
            else if (kt > qt) { const float tb = __builtin_amdgcn_exp2f(lgb * (float)(-dbase));
#pragma unroll
                for (int i = 0; i < 16; ++i) s[i] *= tb * cb16[i]; }
            else { const float tf = __builtin_amdgcn_exp2f(lgf * (float)dbase), tb = __builtin_amdgcn_exp2f(lgb * (float)(-dbase));
#pragma unroll
                for (int i = 0; i < 16; ++i) { const int cr = (i & 3) + 8 * (i >> 2); s[i] *= (cr <= dbase) ? tf * cf16[i] : tb * cb16[i]; } }
#pragma unroll
            for (int st = 0; st < 2; ++st) {
                v4u pk; pk.x = cvtpk(s[8 * st], s[8 * st + 1]); pk.y = cvtpk(s[8 * st + 2], s[8 * st + 3]); pk.z = cvtpk(s[8 * st + 4], s[8 * st + 5]); pk.w = cvtpk(s[8 * st + 6], s[8 * st + 7]);
                const bf16x8v pf = __builtin_bit_cast(bf16x8v, pk);
#pragma unroll
                for (int dt = 0; dt < 2; ++dt) {
                    const LAS unsigned char* vr = base + RO_V + (32 * dt + r31) * RO_VP + (kt * 32 + 16 * st + 4 * hh) * 2;
                    const u32x2v v0 = *(const LAS u32x2v*)vr, v1 = *(const LAS u32x2v*)(vr + 16);
                    v4u vv; vv.x = v0.x; vv.y = v0.y; vv.z = v1.x; vv.w = v1.y;
                    o[dt] = MFMA32(__builtin_bit_cast(bf16x8v, vv), pf, o[dt]);
                }
            }
        }
        float sm = 0.f;
#pragma unroll
        for (int dt = 0; dt < 2; ++dt)
#pragma unroll
            for (int i = 0; i < 16; ++i) sm += o[dt][i];
        sm = xhalf_sum(sm); const float mu = sm * (1.0f / 64.0f); float vr2 = 0.f;
#pragma unroll
        for (int dt = 0; dt < 2; ++dt)
#pragma unroll
            for (int i = 0; i < 16; ++i) { const float t = o[dt][i] - mu; vr2 += t * t; }
        vr2 = xhalf_sum(vr2); const float rs = 1.0f / sqrtf(vr2 * (1.0f / 64.0f) + 1e-6f);
        const float* gn = p.ret_norm_g + (size_t)l * d::RW + head * 64; const bf16* gate = (const bf16*)p.u + (size_t)row * d::INC + d::oRG + head * 64; bf16* orow = p.mixbf + (size_t)row * d::D + d::AW + head * 64;
#pragma unroll
        for (int dt = 0; dt < 2; ++dt)
#pragma unroll
            for (int rg = 0; rg < 4; ++rg) { const int e0 = 32 * dt + 8 * rg + 4 * hh; const f32x4v g4 = *(const f32x4v*)(gn + e0); const u32x2v tw = *(const u32x2v*)(gate + e0); const f32x4v t4v = (f32x4v){BFLO(tw.x), BFHI(tw.x), BFLO(tw.y), BFHI(tw.y)};
                const float y0 = (o[dt][4 * rg] - mu) * rs * g4.x * fast_silu(t4v.x), y1 = (o[dt][4 * rg + 1] - mu) * rs * g4.y * fast_silu(t4v.y);
                const float y2 = (o[dt][4 * rg + 2] - mu) * rs * g4.z * fast_silu(t4v.z), y3 = (o[dt][4 * rg + 3] - mu) * rs * g4.w * fast_silu(t4v.w);
                u32x2v ov; ov.x = cvtpk(y0, y1); ov.y = cvtpk(y2, y3); *(u32x2v*)(orow + e0) = ov; }
    }
    __syncthreads();
}
constexpr int CV_HG = 0, CV_W = 94 * 512, CV_P = CV_W + 31 * 1024;
__device__ __forceinline__ void conv_unit(const OP& p, const PrepBufs& pb, LAS unsigned char* lds, int l, int u, int tid_, int lane_, int wave) {
    typedef Dims d;
    int tid = tid_; asm volatile("" : "+v"(tid)); const int lane = tid & 63;
    const int r0 = u * 64; const int kind = r0 >= d::NL ? 1 : 0; const int t0 = kind ? (r0 - d::NL) % d::C : r0 % d::S, L = kind ? d::C : d::S;
    __syncthreads();
    {
        v4u hv[6]; f32x4v wv[4];
#pragma unroll
        for (int i = 0; i < 6; ++i) { const int c = tid + MK_THREADS * i, lr = c >> 5, part = c & 31, t = t0 - 15 + lr; const bool ok = (c < 94 * 32) && t >= 0 && t < L;
            hv[i] = *(const v4u*)(pb.hglu + (size_t)(ok ? r0 - 15 + lr : r0) * d::CW + part * 8); if (!ok) hv[i] = (v4u){0u, 0u, 0u, 0u}; }
#pragma unroll
        for (int i = 0; i < 4; ++i) { const int c = tid + MK_THREADS * i; wv[i] = *(const f32x4v*)(p.conv_w + (size_t)l * 31 * d::CW + (c < 31 * 64 ? c : 0) * 4); }
#pragma unroll
        for (int i = 0; i < 6; ++i) { const int c = tid + MK_THREADS * i; if (c < 94 * 32) *(LAS v4u*)(lds + CV_HG + (c >> 5) * 512 + (c & 31) * 16) = hv[i]; }
#pragma unroll
        for (int i = 0; i < 4; ++i) { const int c = tid + MK_THREADS * i; if (c < 31 * 64) *(LAS f32x4v*)(lds + CV_W + c * 16) = wv[i]; }
    }
    if (tid < 192) { const int which = tid >> 6, cc = tid & 63; const float* src = which == 0 ? p.conv_b : (which == 1 ? p.conv_norm_g : p.conv_norm_b);
        *(LAS f32x4v*)(lds + CV_P + which * 1024 + cc * 16) = *(const f32x4v*)(src + (size_t)l * d::CW + cc * 4); }
    __syncthreads();
    for (int i = 0; i < 8; ++i) {
        const int lr = wave + 8 * i; int lo = lane * 4; asm volatile("" : "+v"(lo));
        f32x4v acc = *(const LAS f32x4v*)(lds + CV_P + lo * 4);
#pragma unroll
        for (int j = 0; j < 31; ++j) { const u32x2v hv = *(const LAS u32x2v*)(lds + CV_HG + (lr + j) * 512 + lo * 2); const f32x4v wv = *(const LAS f32x4v*)(lds + CV_W + j * 1024 + lo * 4);
            acc += (f32x4v){__builtin_bit_cast(float, hv.x << 16), __builtin_bit_cast(float, hv.x & 0xffff0000u), __builtin_bit_cast(float, hv.y << 16), __builtin_bit_cast(float, hv.y & 0xffff0000u)} * wv; }
        const float mu = wave_sum((acc.x + acc.y) + (acc.z + acc.w)) * (1.0f / d::CW); const f32x4v dv = acc - mu;
        const float rs = 1.0f / sqrtf(wave_sum((dv.x * dv.x + dv.y * dv.y) + (dv.z * dv.z + dv.w * dv.w)) * (1.0f / d::CW) + 1e-6f);
        const f32x4v g4 = *(const LAS f32x4v*)(lds + CV_P + 1024 + lo * 4), b4 = *(const LAS f32x4v*)(lds + CV_P + 2048 + lo * 4); const f32x4v y = dv * rs * g4 + b4;
        u32x2v ov; ov.x = cvtpk(fast_silu(y.x), fast_silu(y.y)); ov.y = cvtpk(fast_silu(y.z), fast_silu(y.w));
        *(u32x2v*)(p.mixbf + (size_t)(r0 + lr) * d::D + d::AW + d::RW + lo) = ov;
    }
}
__device__ __forceinline__ void phase_mix(const OP& p, const PrepBufs& pb, LAS unsigned char* lds, unsigned* qctr, int l, bool last) {
    typedef Dims d;
    int t_ = threadIdx.x; asm volatile("" : "+v"(t_)); const int tid = t_, lane = tid & 63, wave = __builtin_amdgcn_readfirstlane(tid >> 6);
    constexpr int NS = d::B * d::RH, NUL = d::B * (d::S / 128) * d::KVH, NUC = d::B * (d::C / 128) * d::KVH;
    const int NA = NUL + (last ? 0 : NUC), NCV = (last ? d::NL : d::NR) / 64, NT = NS + NA + NCV;
    LAS int* qslot = (LAS int*)(lds + MISC_OFF + 64);
    for (;;) {
        __syncthreads();
        if (tid == 0) qslot[0] = (int)__hip_atomic_fetch_add(qctr, 1u, __ATOMIC_RELAXED, __HIP_MEMORY_SCOPE_AGENT);
        __syncthreads();
        const int v = qslot[0];
        if (v >= NT) break;
        if (v < NS) ret_state_unit(p, pb, l, v / d::RH, v % d::RH, lane, wave);
        else if (v < NS + NA) { const int u = v - NS; int kind, b, qblk, kvh;
            if (u < NUL) { kind = 0; kvh = u % d::KVH; qblk = (u / d::KVH) % (d::S / 128); b = u / (d::KVH * (d::S / 128)); }
            else { const int w = u - NUL; kind = 1; kvh = w % d::KVH; qblk = (w / d::KVH) % (d::C / 128); b = w / (d::KVH * (d::C / 128)); }
            att_unit(p, pb, lds, l, kind, b, qblk, kvh, tid, lane, wave); }
        else conv_unit(p, pb, lds, l, v - NS - NA, tid, lane, wave);
    }
    __syncthreads();
}

__global__ void __launch_bounds__(MK_THREADS, 2) mk_fwd(const OP p, const PrepBufs pb, unsigned* ctl) {
    extern __shared__ __attribute__((aligned(16))) unsigned char lds[];
    if (threadIdx.x < 64) ((LAS unsigned*)(lds + MISC_OFF))[threadIdx.x] = 0u;
    __syncthreads();
    (void)xcd_barrier_post(ctl + CW_BAR, (volatile LAS unsigned*)(lds + MISC_OFF));
#define GRID_BAR() do { XcdBarrier b_; b_.bar = ctl + CW_BAR; b_.x = xb_xcc_id(); b_.st = (volatile LAS unsigned*)(lds + MISC_OFF); xcd_barrier(b_); } while (0)
    const int G = gridDim.x, ngw = G * 8;
    LAS unsigned char* ldsp = (LAS unsigned char*)lds;
#define MK_CONV(...) do { int _t = threadIdx.x; asm volatile("" : "+v"(_t)); const int lane = _t & 63, wave = __builtin_amdgcn_readfirstlane(_t >> 6); const int gw = blockIdx.x * 8 + wave; LAS float* scr = (LAS float*)(ldsp + wave * 16384); conv_group(__VA_ARGS__, scr, gw, ngw, lane); } while (0)
    const Dims& d = p.d;
    MK_CONV(p.w_in, (size_t)d.D * d.INC, d.DEPTH, d.D, d.INC, p.wInT, (size_t)d.INC * d.D, 0);
    MK_CONV(p.w_out, (size_t)d.D * d.D, d.DEPTH, d.D, d.D, p.wOutT, (size_t)d.D * d.D, 0);
    __syncthreads();
    phase_mod(p, ldsp, G); GRID_BAR();
    phase_rows<8>(p, ldsp, G, p.x, p.ctx, d.NR, 0, 0, 0); GRID_BAR();
#pragma unroll
    for (int l = 0; l < d.DEPTH; ++l) {
        const bool last = (l == d.DEPTH - 1);
        {
            pg8::Gemm g{p.hbf, p.wInT + (size_t)l * d.INC * d.D, d.D}; pg8::WinOrder S;
            if (last) S.init(d.NL / 256, (d.NR - d.NL) / 256, d.INC / 256, 3, 0x542, G, (int)blockIdx.x); else S.init(d.NR / 256, 0, d.INC / 256, 0, 0, G, (int)blockIdx.x);
            pg8::EpiBf16 E{(bf16*)p.u, d.INC};
            pg8::gemm_phase(ldsp, g, S, E);
        }
        if (l == 0) conv_ffn_dyn(p, l, ctl + CW_QUEUE + 64 * l + 32, ldsp, 0, 2 * d.E * 176); else conv_ffn_dyn(p, l, ctl + CW_QUEUE + 64 * l + 33, ldsp, 2 * d.E * 176, d.E * 176);
        GRID_BAR();
        phase_prep<7>(p, pb, ldsp, G, l, last); GRID_BAR();
        phase_mix(p, pb, ldsp, ctl + CW_QUEUE + 64 * l, l, last); GRID_BAR();
        phase_retout(p, pb, ldsp, G, l, last);
        if (l == 0) conv_ffn_dyn(p, l, ctl + CW_QUEUE + 64 * l + 35, ldsp, 2 * d.E * 176, d.E * 88);
        GRID_BAR();
        const int mrows = last ? d.NL : d.NR;
        {
            pg8::Gemm g{p.mixbf, p.wOutT + (size_t)l * d.D * d.D, d.D}; pg8::DenseOrder S; S.init(mrows / 256, d.D / 256, G, (int)blockIdx.x);
            pg8::EpiResid E{p.xcur, l == 0 ? p.x : p.xcur, l == 0 ? p.ctx : p.xcur + (size_t)d.NL * d.D, d.D, p.mod + (size_t)l * (d.B + 1) * 6 * d.D, 2 * d.D, d.NL, d.S, d.B};
            pg8::gemm_phase(ldsp, g, S, E);
            if (l == 0) conv_ffn_dyn(p, l, ctl + CW_QUEUE + 64 * l + 33, ldsp, 2 * d.E * 176 + d.E * 88, d.E * 88);
            GRID_BAR();
        }
        phase_router(p, ldsp, G, p.xcur, p.xcur + (size_t)d.NL * d.D, mrows, l); GRID_BAR();
        phase_topk(p, ldsp, G, !last); GRID_BAR();
        {
            pg8::Gemm g{p.hbf, p.ffnW1, d.D / 2, p.rowidx, TBL_OFF}; pg8::ExpertOrder S; S.init(2 * d.FF / 256, d.NSL / d.E / 256, last ? 0 : d.NSC / d.E / 256, d.E, G, (int)blockIdx.x);
            pg8::EpiSwiGLU8T E{(unsigned char*)p.hmidb, d.FF / 128, -LOG2E / W1_SCALE, W1_SCALE * W1_SCALE / H_SCALE};
            pg8::gemm_phase<pg8::EpiSwiGLU8T, pg8::ExpertOrder, true, true, true, false, true, true>(ldsp, g, S, E); GRID_BAR();
        }
        {
            pg8::Gemm g{p.hmidb, p.ffnW2, d.FF / 2}; pg8::ExpertOrder S; S.init(d.D / 256, d.NSL / d.E / 256, last ? 0 : d.NSC / d.E / 256, d.E, G, (int)blockIdx.x);
            pg8::EpiDown E{p.ybufb, d.D, p.gate, 1.0f / (W2_SCALE * H_SCALE)};
            pg8::gemm_phase<pg8::EpiDown, pg8::ExpertOrder, true, true, true, true, true>(ldsp, g, S, E);
            if (!last) conv_ffn_dyn(p, l + 1, ctl + CW_QUEUE + 64 * l + 34, ldsp, 0, 2 * d.E * 176);
            GRID_BAR();
        }
        if (!last) { phase_rows<1 | 2 | 8>(p, ldsp, G, p.xcur, p.xcur + (size_t)d.NL * d.D, d.NR, l, l + 1, 0); GRID_BAR(); }
        else { phase_rows<1 | 4>(p, ldsp, G, p.xcur, p.xcur + (size_t)d.NL * d.D, d.NL, l, l, 0); }
    }
}

static inline void fill_inputs(OP& p, void* const* d_in) {
    p.x = (const float*)d_in[0]; p.c = (const float*)d_in[1]; p.ctx = (const float*)d_in[2]; p.c_ctx = (const float*)d_in[3]; p.w_mod = (const float*)d_in[4]; p.b_mod = (const float*)d_in[5];
    p.g_mix = (const float*)d_in[6]; p.g_ffn = (const float*)d_in[7]; p.w_in = (const float*)d_in[8]; p.q_norm_g = (const float*)d_in[9]; p.k_norm_g = (const float*)d_in[10]; p.att_sink = (const float*)d_in[11];
    p.ret_decay_logit = (const float*)d_in[12]; p.ret_norm_g = (const float*)d_in[13]; p.conv_w = (const float*)d_in[14]; p.conv_b = (const float*)d_in[15]; p.conv_norm_g = (const float*)d_in[16];
    p.conv_norm_b = (const float*)d_in[17]; p.w_out = (const float*)d_in[18]; p.w_router = (const float*)d_in[19]; p.w_gate = (const float*)d_in[20]; p.w_up = (const float*)d_in[21]; p.w_down = (const float*)d_in[22];
}
static inline size_t carve_ws(OP& p, PrepBufs& pb, unsigned char* ws) {
    const Dims& d = p.d; size_t off = WS_CTL_BYTES;
    auto take = [&](size_t bytes) { void* q = ws + off; off += (bytes + 255) & ~(size_t)255; return q; };
    const size_t NR = d.NR, D = d.D;
    p.wInT = (bf16*)take((size_t)d.DEPTH * d.INC * D * 2); p.wOutT = (bf16*)take((size_t)d.DEPTH * D * D * 2);
    p.ffnW1 = (bf16*)take((size_t)d.E * 2 * d.FF * D * 2); p.ffnW2 = (bf16*)take((size_t)d.E * D * d.FF * 2);
    p.mod = (float*)take((size_t)d.DEPTH * (d.B + 1) * 6 * D * 4);
    p.xcur = (float*)take(NR * D * 4);
    p.hbf = (bf16*)take(NR * D * 2); p.mixbf = (bf16*)take(NR * D * 2);
    p.aff = (float*)take(NR * d.E * 4);
    p.rowidx = (int*)take((size_t)(d.NSL + d.NSC) * 4); p.gate = (float*)take((size_t)(d.NSL + d.NSC) * 4); p.slotof = (int*)take(NR * d.E * 4);
    { const size_t a0 = off; p.u = (float*)take(NR * d.INC * 4); p.hmidb = (bf16*)(ws + a0);
      const size_t need = (size_t)(d.NSL + d.NSC) * d.FF * 2; if (off - a0 < need) off = a0 + ((need + 255) & ~(size_t)255); }
    { const size_t b0 = off; pb.qb = (bf16*)take(NR * d.AW * 2); pb.kb = (bf16*)take(NR * d.KVW * 2);
      pb.vTl = (bf16*)take((size_t)d.B * d.KVH * 64 * d.S * 2); pb.vTc = (bf16*)take((size_t)d.B * d.KVH * 64 * d.C * 2);
      pb.rqb = (bf16*)take(NR * d.RW * 2); pb.rkb = (bf16*)take(NR * d.RW * 2);
      pb.rkTl = (bf16*)take((size_t)d.B * d.RH * 64 * d.S * 2); pb.rkTc = (bf16*)take((size_t)d.B * d.RH * 64 * d.C * 2);
      pb.rvTl = (bf16*)take((size_t)d.B * d.RH * 64 * d.S * 2); pb.rvTc = (bf16*)take((size_t)d.B * d.RH * 64 * d.C * 2);
      pb.hglu = (bf16*)take(NR * d.CW * 2); pb.sprevT = (bf16*)take((size_t)d.B * 2 * d.NCH * d.RH * 4096 * 2);
      const size_t xb = (size_t)(d.NSL + d.NSC) * D * 2; p.xe = (bf16*)(ws + b0); p.ybufb = (bf16*)(ws + b0 + ((xb + 255) & ~(size_t)255));
      const size_t need = 2 * ((xb + 255) & ~(size_t)255); if (off - b0 < need) off = b0 + need; }
    return off;
}
extern "C" void kernel_launch(void* const* d_in, const int* in_sizes, int n_in, void* d_out, int out_size, void* d_ws, size_t ws_size, hipStream_t stream) {
    (void)in_sizes; (void)n_in; (void)out_size;
    static int grid = 0;
    if (grid == 0) {
        int dev = 0, cus = 0, per_cu = 0;
        if (hipGetDevice(&dev) != hipSuccess || hipDeviceGetAttribute(&cus, hipDeviceAttributeMultiprocessorCount, dev) != hipSuccess) { fprintf(stderr, "kernel_launch: device query failed\n"); grid = -1; return; }
        if (hipFuncSetAttribute((const void*)mk_fwd, hipFuncAttributeMaxDynamicSharedMemorySize, LDS_BYTES) != hipSuccess) { fprintf(stderr, "kernel_launch: hipFuncSetAttribute failed\n"); grid = -1; return; }
        if (hipOccupancyMaxActiveBlocksPerMultiprocessor(&per_cu, (const void*)mk_fwd, MK_THREADS, LDS_BYTES) != hipSuccess || per_cu < 1) { fprintf(stderr, "kernel_launch: occupancy query says %d blocks per CU\n", per_cu); }
        (void)hipGetLastError();
        grid = cus;
    }
    if (grid < 0) return;
    OP p; memset(&p, 0, sizeof(p)); const Dims& d = p.d;
    {
        const int per = (2 * d.FF / 256) * ((d.NSL + d.NSC) / d.E / 256), tot = d.E * per;
        const int per_wg = (grid % 8 == 0 && d.E % 8 == 0) ? ((d.E / 8) * per + grid / 8 - 1) / (grid / 8) : (tot + grid - 1) / grid;
        if (per_wg > TBL_UNITS) { fprintf(stderr, "kernel_launch: %d expert-GEMM units per workgroup exceed the LDS row-index table (%d)\n", per_wg, TBL_UNITS); return; }
    }
    fill_inputs(p, d_in);
    PrepBufs pb; memset(&pb, 0, sizeof(pb));
    const size_t used = carve_ws(p, pb, (unsigned char*)d_ws);
    if (used > ws_size) { fprintf(stderr, "kernel_launch: workspace too small (%zu > %zu)\n", used, ws_size); return; }
    p.out = (float*)d_out;
    if (hipMemsetAsync(d_ws, 0, WS_CTL_BYTES, stream) != hipSuccess) { fprintf(stderr, "kernel_launch: memset failed\n"); return; }
    unsigned* ctl = (unsigned*)d_ws;
    hipLaunchKernelGGL(mk_fwd, dim3(grid), dim3(MK_THREADS), LDS_BYTES, stream, p, pb, ctl);
    const hipError_t le = hipPeekAtLastError();
    if (le != hipSuccess) fprintf(stderr, "kernel_launch: launch failed: %s\n", hipGetErrorName(le));
}
```

```cpp
#include <hip/hip_runtime.h>
#include <cstdio>
#include <cmath>
#include <cstdint>
#define HD_ __host__ __device__ __forceinline__
struct Dims {
    static constexpr int B = 16, S = 2048, C = 256, D = 1024, DEPTH = 2, GRID_W = 64, AH = 8, KVH = 2, RH = 4, E = 16, FF = 2816;
    static constexpr int AW = AH * 64, KVW = KVH * 64, RW = RH * 64, CW = D - AW - RW, INC = AW + 2 * KVW + 4 * RW + 2 * CW;
    static constexpr int NL = B * S, NR = B * (S + C), NCc = C / 128, NCl = S / 128, NCH = NCc + NCl;
    static constexpr int capL = 2 * S / E, capC = 2 * C / E, NSL = B * E * capL, NSC = B * E * capC, G = AH / KVH;
    static constexpr int oAQ = 0, oAK = AW, oAV = AW + KVW, oRQ = AW + 2 * KVW, oRK = oRQ + RW, oRV = oRK + RW, oRG = oRV + RW, oCV = oRG + RW;
    int pad_;
};

struct OP {
    Dims d;
    const float *x, *c, *ctx, *c_ctx, *w_mod, *b_mod, *g_mix, *g_ffn, *w_in, *q_norm_g, *k_norm_g, *att_sink, *ret_decay_logit,
        *ret_norm_g, *conv_w, *conv_b, *conv_norm_g, *conv_norm_b, *w_out, *w_router, *w_gate, *w_up, *w_down;
    float *mod;
    float *xcur;
    float *u;
    float *aff;
    int *rowidx;
    float *gate;
    int *slotof;
    float *out;
    unsigned short *hbf, *mixbf, *xe, *hmidb, *ybufb, *wInT, *wOutT, *ffnW1, *ffnW2;
};

#define XB_TMO      128
#define XB_XCNT(j)  (256  + 64 * (j))
#define XB_XSUB(j)  (1280 + 64 * (j))
#define XB_XGEN(j)  (2304 + 64 * (j))
#define XB_TOP      3328
#define XB_TOPGEN   3392
#define XCD_BAR_WORDS 3456
#define XB_SPIN_CAP (1u << 18)
#define LAS __attribute__((address_space(3)))

__device__ __forceinline__ unsigned xb_ld(unsigned* p)              { return __hip_atomic_load(p, __ATOMIC_RELAXED, __HIP_MEMORY_SCOPE_AGENT); }
__device__ __forceinline__ unsigned xb_add(unsigned* p, unsigned v) { return __hip_atomic_fetch_add(p, v, __ATOMIC_RELAXED, __HIP_MEMORY_SCOPE_AGENT); }
__device__ __forceinline__ unsigned xb_xcc_id() { return (unsigned)__builtin_amdgcn_s_getreg((3 << 11) | 20) & 0xFu; }
#define XB_SPIN(cond, bar) do { unsigned _sp = 0; while (cond) { __builtin_amdgcn_s_sleep(1); \
    if ((++_sp & 255u) == 0u) { if (xb_ld(&(bar)[XB_TMO])) break; if (_sp > XB_SPIN_CAP) { atomicAdd(&(bar)[XB_TMO], 1u); break; } } } } while (0)

struct XcdBarrier {
    unsigned* bar; unsigned x;
    volatile LAS unsigned* st;
};

__device__ __forceinline__ XcdBarrier xcd_barrier_post(unsigned* bar, volatile LAS unsigned* st) {
    XcdBarrier b; b.bar = bar; b.x = xb_xcc_id(); b.st = st;
    if (threadIdx.x == 0) (void)xb_add(&bar[XB_XCNT(b.x)], 1u);
    return b;
}
__device__ __forceinline__ void xcd_barrier_complete(unsigned* bar, unsigned x, unsigned& nloc, unsigned& nx) {
    const unsigned G = gridDim.x * gridDim.y * gridDim.z;
    unsigned sum, cnt, mine, sp = 0u;
    for (;;) {
        sum = 0u; cnt = 0u; mine = 0u;
#pragma unroll
        for (unsigned j = 0; j < 16; ++j) { const unsigned c = xb_ld(&bar[XB_XCNT(j)]); sum += c; cnt += (c > 0u) ? 1u : 0u; mine = (j == x) ? c : mine; }
        if (sum == G) break;
        __builtin_amdgcn_s_sleep(1);
        if ((++sp & 255u) == 0u) { if (xb_ld(&bar[XB_TMO])) break; if (sp > XB_SPIN_CAP) { atomicAdd(&bar[XB_TMO], 1u); break; } }
    }
    nloc = mine > 0u ? mine : 1u; nx = cnt > 0u ? cnt : 1u;
}

__device__ __forceinline__ void xcd_barrier(const XcdBarrier& b) {
    asm volatile("s_waitcnt vmcnt(0)" ::: "memory");
    __syncthreads();
    if (threadIdx.x == 0) {
        unsigned* bar = b.bar;
        __builtin_amdgcn_s_waitcnt(0);
        unsigned nloc = b.st[0], nx = b.st[1];
        if (nloc == 0u) { xcd_barrier_complete(bar, b.x, nloc, nx); b.st[0] = nloc; b.st[1] = nx; }
        const unsigned old = xb_add(&bar[XB_XSUB(b.x)], 1u);
        const unsigned gen = old / nloc;
        if (old + 1u == (gen + 1u) * nloc) {
            __builtin_amdgcn_fence(__ATOMIC_RELEASE, "agent");
            asm volatile("s_waitcnt vmcnt(0)" ::: "memory");
            const unsigned og = xb_add(&bar[XB_TOP], 1u);
            const unsigned tg = og / nx;
            if (og + 1u == (tg + 1u) * nx) xb_add(&bar[XB_TOPGEN], 1u);
            else XB_SPIN(xb_ld(&bar[XB_TOPGEN]) == tg, bar);
            __builtin_amdgcn_fence(__ATOMIC_ACQUIRE, "agent");
            xb_add(&bar[XB_XGEN(b.x)], 1u);
            asm volatile("s_waitcnt vmcnt(0)" ::: "memory");
        } else {
            XB_SPIN(xb_ld(&bar[XB_XGEN(b.x)]) == gen, bar);
            __builtin_amdgcn_fence(__ATOMIC_ACQUIRE, "agent");
            asm volatile("s_waitcnt vmcnt(0)" ::: "memory");
        }
    }
    __syncthreads();
}
namespace pg8 {
#define PG8_LAS __attribute__((address_space(3)))
typedef unsigned short bf16_t;
typedef short bf16x8 __attribute__((ext_vector_type(8)));
typedef float f32x4 __attribute__((ext_vector_type(4)));
typedef float f32x2 __attribute__((ext_vector_type(2)));
typedef unsigned u32x4 __attribute__((ext_vector_type(4)));
typedef unsigned u32x2 __attribute__((ext_vector_type(2)));
constexpr int BM = 256, BK = 64, HALF = 128, HTB = HALF * BK * 2  , STAGE_BYTES = 8 * HTB, NXCD = 8, WGM = 8;

__host__ __device__ __forceinline__ int lds_byte(int r, int c) { const int st = (r >> 4) * 2 + (c >> 5), rr = r & 15, cc = c & 31, ob = rr * 64 + cc * 2; return st * 1024 + (ob ^ (((ob >> 9) & 1) << 5)); }
__host__ __device__ __forceinline__ void stage_rc(int b, int& R, int& C) { const int st = b / 1024, sb = b % 1024, swz = sb ^ (((sb >> 9) & 1) << 5); R = (st >> 1) * 16 + swz / 64; C = (st & 1) * 32 + (swz % 64) / 2; }
__host__ __device__ __forceinline__ int perm32(int rho) { const int n = rho >> 4, i = rho & 15; return 8 * (i >> 2) + 4 * n + (i & 3); }

struct Unit { int pm, pn, pb; };
struct Gemm { const bf16_t* A; const bf16_t* Bt; int K; const int* ridx; int tbl_off; };

struct DenseOrder {
    int nM, nN, nwg, G, c;
    __device__ void init(int nM_, int nN_, int G_, int c_) { nM = nM_; nN = nN_; nwg = nM * nN; G = G_; c = c_; }
    __device__ bool next(int i, Unit& u) const {
        const long L = (long)i * G + c; if (L >= nwg) return false;
        int wgid = (int)L; { const int q = nwg / NXCD, r = nwg % NXCD, xcd = wgid % NXCD, off = wgid / NXCD; wgid = (xcd < r ? xcd * (q + 1) : r * (q + 1) + (xcd - r) * q) + off; }
        const int nig = WGM * nN, gid = wgid / nig, fm = gid * WGM, gsz = (nM - fm) < WGM ? (nM - fm) : WGM;
        u.pm = fm + ((wgid % nig) % gsz); u.pn = (wgid % nig) / gsz; u.pb = u.pn; return true;
    }
};
struct WinOrder {
    DenseOrder dn; int nLat, nCtx, ncx, cols, G, c;
    __device__ void init(int nLat_, int nCtx_, int nN_, int ncx_, int cols_, int G_, int c_) { dn.init(nLat_, nN_, G_, c_); nLat = nLat_; nCtx = nCtx_; ncx = ncx_; cols = cols_; G = G_; c = c_; }
    __device__ bool next(int i, Unit& u) const {
        const long L = (long)i * G + c; const int nd = dn.nwg;
        if (L < nd) return dn.next(i, u);
        const int idx = (int)(L - nd); if (idx >= nCtx * ncx) return false;
        u.pm = nLat + idx / ncx; u.pn = (cols >> (4 * (idx % ncx))) & 15; u.pb = u.pn; return true;
    }
};
struct ExpertOrder {
    int nN, tpeL, tpeC, nE, G, c, nwg;
    __device__ void init(int nN_, int tpeL_, int tpeC_, int nE_, int G_, int c_) { nN = nN_; tpeL = tpeL_; tpeC = tpeC_; nE = nE_; G = G_; c = c_; nwg = nE * nN * (tpeL + tpeC); }
    __device__ bool next(int i, Unit& u) const {
        const unsigned tpe = (unsigned)(tpeL + tpeC), per = (unsigned)nN * tpe; unsigned e, j;
        if ((G & 7) == 0 && (nE & 7) == 0) { const unsigned Wx = (unsigned)G >> 3, x = (unsigned)c & 7u, r = (unsigned)c >> 3; unsigned jx = (unsigned)i * Wx + r; if (jx >= ((unsigned)nE >> 3) * per) return false;
            const unsigned ei = (jx >= per ? 1u : 0u) + (jx >= 2u * per ? 1u : 0u) + (jx >= 3u * per ? 1u : 0u); e = x + 8u * ei; j = jx - ei * per; }
        else { unsigned L = (unsigned)i * (unsigned)G + (unsigned)c; if (L >= (unsigned)nwg) return false; e = 0u; while (L >= per) { L -= per; ++e; } j = L; }
        const unsigned PW = nN < 8 ? (unsigned)nN : 8u, grp = PW * tpe; const unsigned pg = (j >= grp ? 1u : 0u) + (j >= 2u * grp ? 1u : 0u) + (j >= 3u * grp ? 1u : 0u); j -= pg * grp;
        const unsigned rest = (unsigned)nN - pg * PW, w = rest < PW ? rest : PW;
        unsigned mt;
        if (w == 8u) mt = j >> 3; else if (w == 4u) mt = j >> 2; else if (w == 6u) mt = (j * 10923u) >> 16; else { mt = 0u; for (unsigned t = j; t >= w; t -= w) ++mt; }
        const unsigned pn = pg * PW + (j - mt * w);
        u.pm = (int)(mt < (unsigned)tpeL ? e * (unsigned)tpeL + mt : (unsigned)nE * (unsigned)tpeL + e * (unsigned)tpeC + (mt - (unsigned)tpeL)); u.pn = (int)pn; u.pb = (int)(e * (unsigned)nN + pn); return true;
    }
};

typedef int i32x8 __attribute__((ext_vector_type(8)));
typedef int i32x4 __attribute__((ext_vector_type(4)));
__device__ __forceinline__ i32x8 cat8(const bf16x8 a, const bf16x8 b) { return __builtin_shufflevector(__builtin_bit_cast(i32x4, a), __builtin_bit_cast(i32x4, b), 0, 1, 2, 3, 4, 5, 6, 7); }
__device__ __forceinline__ unsigned pk4_fp8(float a, float b, float c, float d) { int r = 0; r = __builtin_amdgcn_cvt_pk_fp8_f32(a, b, r, false); r = __builtin_amdgcn_cvt_pk_fp8_f32(c, d, r, true); return (unsigned)r; }
__device__ __forceinline__ unsigned cvt_pk_bf16(float lo, float hi) { unsigned r; asm volatile("v_cvt_pk_bf16_f32 %0, %1, %2" : "=v"(r) : "v"(lo), "v"(hi)); return r; }

struct EpiBf16 {
    static constexpr bool PERM = true; static constexpr int NSTORE = 16;
    bf16_t* O; int ldc;
    __device__ __forceinline__ void operator()(const f32x4 (&acc)[2][2][4][2], const Unit& u, int wr, int wc, int fr, int fq) const {
        const int row0 = u.pm * BM + wr * 64 + fr, col0 = u.pn * BM + wc * 32 + 8 * fq;
#pragma unroll
        for (int ai = 0; ai < 2; ++ai)
#pragma unroll
            for (int m = 0; m < 4; ++m) { bf16_t* rowp = O + (size_t)(row0 + ai * HALF + m * 16) * ldc + col0;
#pragma unroll
                for (int bj = 0; bj < 2; ++bj) { const f32x4 v0 = acc[ai][bj][m][0], v1 = acc[ai][bj][m][1];
                    u32x4 w; w.x = cvt_pk_bf16(v0[0], v0[1]); w.y = cvt_pk_bf16(v0[2], v0[3]); w.z = cvt_pk_bf16(v1[0], v1[1]); w.w = cvt_pk_bf16(v1[2], v1[3]);
                    *(u32x4*)(rowp + bj * HALF) = w; } }
    }
};
struct EpiResid {
    static constexpr bool PERM = false; static constexpr int NSTORE = 32;
    float* X; const float* srcL; const float* srcC; int ldc; const float* mod; int gate_off; int NL, S, B;
    __device__ __forceinline__ void operator()(const f32x4 (&acc)[2][2][4][2], const Unit& u, int wr, int wc, int fr, int fq) const {
        const int row0 = u.pm * BM + wr * 64 + fr, col0 = u.pn * BM + wc * 32 + 4 * fq;
        const int rt = u.pm * BM; const int mi = rt < NL ? rt / S : B;
        const float* sb = rt < NL ? srcL : srcC - (size_t)NL * ldc;
        const float* gp = mod + (size_t)mi * 6 * ldc + gate_off + col0;
        f32x4 gv[2][2];
#pragma unroll
        for (int bj = 0; bj < 2; ++bj)
#pragma unroll
            for (int n = 0; n < 2; ++n) gv[bj][n] = *(const f32x4*)(gp + bj * HALF + n * 16);
#pragma unroll
        for (int ai = 0; ai < 2; ++ai)
#pragma unroll
            for (int m = 0; m < 4; ++m) { const size_t ro = (size_t)(row0 + ai * HALF + m * 16) * ldc + col0;
#pragma unroll
                for (int bj = 0; bj < 2; ++bj)
#pragma unroll
                    for (int n = 0; n < 2; ++n) *(f32x4*)(X + ro + bj * HALF + n * 16) = *(const f32x4*)(sb + ro + bj * HALF + n * 16) + gv[bj][n] * acc[ai][bj][m][n]; }
    }
};
__device__ __forceinline__ float silu_f(float x) { return x * __builtin_amdgcn_rcpf(1.0f + __expf(-x)); }
struct EpiSwiGLU8 {
    static constexpr bool PERM = true; static constexpr int NSTORE = 8;
    unsigned char* H; int ldh; float iscale, oscale;
    __device__ __forceinline__ void operator()(const f32x4 (&acc)[2][2][4][2], const Unit& u, int wr, int wc, int fr, int fq) const {
        const int row0 = u.pm * BM + wr * 64 + fr, col0 = u.pn * HALF + wc * 32 + 8 * fq; const float os = oscale * iscale;
#pragma unroll
        for (int ai = 0; ai < 2; ++ai)
#pragma unroll
            for (int m = 0; m < 4; ++m) { unsigned char* rowp = H + (size_t)(row0 + ai * HALF + m * 16) * ldh + col0;
                const f32x4 g0 = acc[ai][0][m][0] * iscale, g1 = acc[ai][0][m][1] * iscale, u0 = acc[ai][1][m][0] * os, u1 = acc[ai][1][m][1] * os;
                u32x2 w; w.x = pk4_fp8(silu_f(g0[0]) * u0[0], silu_f(g0[1]) * u0[1], silu_f(g0[2]) * u0[2], silu_f(g0[3]) * u0[3]);
                w.y = pk4_fp8(silu_f(g1[0]) * u1[0], silu_f(g1[1]) * u1[1], silu_f(g1[2]) * u1[2], silu_f(g1[3]) * u1[3]);
                *(u32x2*)rowp = w; }
    }
};
struct EpiSwiGLU8T {
    static constexpr bool PERM = true; static constexpr int NSTORE = 8;
    unsigned char* H; int nkt; float k1, cinv;
    static __device__ __forceinline__ f32x4 f(const f32x4 ag, const f32x4 au, const float k, const float ci) {
        const f32x4 e = ag * k; f32x4 t; t[0] = __builtin_amdgcn_exp2f(e[0]); t[1] = __builtin_amdgcn_exp2f(e[1]); t[2] = __builtin_amdgcn_exp2f(e[2]); t[3] = __builtin_amdgcn_exp2f(e[3]);
        const f32x4 d = t * ci + ci; f32x4 r; r[0] = __builtin_amdgcn_rcpf(d[0]); r[1] = __builtin_amdgcn_rcpf(d[1]); r[2] = __builtin_amdgcn_rcpf(d[2]); r[3] = __builtin_amdgcn_rcpf(d[3]);
        return (ag * au) * r;
    }
    __device__ __forceinline__ void operator()(const f32x4 (&acc)[2][2][4][2], const Unit& u, int wr, int wc, int fr, int fq) const {
        unsigned char* blk = H + ((size_t)u.pm * nkt + u.pn) * (size_t)(2 * HTB);
#pragma unroll
        for (int ai = 0; ai < 2; ++ai)
#pragma unroll
            for (int m = 0; m < 4; ++m) { unsigned char* rowp = blk + ai * HTB + lds_byte(wr * 64 + m * 16 + fr, wc * 16 + 4 * fq);
                const f32x4 o0 = f(acc[ai][0][m][0], acc[ai][1][m][0], k1, cinv), o1 = f(acc[ai][0][m][1], acc[ai][1][m][1], k1, cinv);
                u32x2 w; w.x = pk4_fp8(o0[0], o0[1], o0[2], o0[3]); w.y = pk4_fp8(o1[0], o1[1], o1[2], o1[3]);
                *(u32x2*)rowp = w; }
    }
};
struct EpiDown {
    static constexpr bool PERM = true; static constexpr int NSTORE = 16;
    bf16_t* Y; int ldc; const float* rowscale; float oscale;
    __device__ __forceinline__ void operator()(const f32x4 (&acc)[2][2][4][2], const Unit& u, int wr, int wc, int fr, int fq) const {
        const int row0 = u.pm * BM + wr * 64 + fr, col0 = u.pn * BM + wc * 32 + 8 * fq;
#pragma unroll
        for (int ai = 0; ai < 2; ++ai)
#pragma unroll
            for (int m = 0; m < 4; ++m) { const int row = row0 + ai * HALF + m * 16; const float g = rowscale[row] * oscale; bf16_t* rowp = Y + (size_t)row * ldc + col0;
#pragma unroll
                for (int bj = 0; bj < 2; ++bj) { const f32x4 v0 = acc[ai][bj][m][0] * g, v1 = acc[ai][bj][m][1] * g;
                    u32x4 w; w.x = cvt_pk_bf16(v0[0], v0[1]); w.y = cvt_pk_bf16(v0[2], v0[3]); w.z = cvt_pk_bf16(v1[0], v1[1]); w.w = cvt_pk_bf16(v1[2], v1[3]);
                    *(u32x4*)(rowp + bj * HALF) = w; } }
    }
};

template <class Epi, class Sched, bool F8 = false, bool SP2 = true, bool ALIGN_EPI = true, bool A_TILED = false, bool B_TILED = false, bool A_GATHER = false>
__device__ __forceinline__ void gemm_phase(PG8_LAS unsigned char* lds, const Gemm g, const Sched& S, const Epi& E) {
    int tid_ = threadIdx.x; asm volatile("" : "+v"(tid_));
    const int tid = tid_, wid = __builtin_amdgcn_readfirstlane(tid >> 6), lane = tid & 63, wr = wid >> 2, wc = wid & 3, fr = lane & 15, fq = lane >> 4;
    const int K = g.K, nt = K / BK;
    unsigned voffA[2], voffB[2];
#pragma unroll
    for (int i = 0; i < 2; ++i) { int R, C; stage_rc(tid * 16 + i * 8192, R, C); const int Rb = Epi::PERM ? ((R & ~31) + perm32(R & 31)) : R;
        voffA[i] = A_TILED ? (unsigned)(tid * 16 + i * 8192) : (unsigned)(R * K + C) * 2u; voffB[i] = B_TILED ? (unsigned)(tid * 16 + i * 8192) : (unsigned)(Rb * K + C) * 2u; }
    unsigned tadr[2], cg[2];
#pragma unroll
    for (int i = 0; i < 2; ++i) { int R, C; stage_rc(tid * 16 + i * 8192, R, C); tadr[i] = (unsigned)(g.tbl_off + R * 2); cg[i] = (unsigned)(C * 2); }
    const size_t kstepA = A_TILED ? (size_t)(2 * HTB) : (size_t)(BK * 2), kstepB = B_TILED ? (size_t)(2 * HTB) : (size_t)(BK * 2);
    const size_t hstepA = A_TILED ? (size_t)HTB : (size_t)HALF * K * 2, hstepB = B_TILED ? (size_t)HTB : (size_t)HALF * K * 2;
    const size_t tstep = (size_t)BM * K * 2;
    const unsigned ldsw = (unsigned)wid * 1024u;
    const int aoff = lds_byte(wr * 64 + fr, fq * 8), boff = lds_byte(wc * 32 + fr, fq * 8);
#define PG8_SA(b, h) (((b) * 2 + (h)) * HTB)
#define PG8_SB(b, h) ((4 + (b) * 2 + (h)) * HTB)
#define PG8_STAGE(bufoff, gbase, voff) do { _Pragma("unroll") for (int _i = 0; _i < 2; ++_i) \
        __builtin_amdgcn_global_load_lds((const unsigned*)((const char*)(gbase) + (voff)[_i]), (PG8_LAS unsigned*)(lds + (bufoff) + ldsw + _i * 8192), 16, 0, 0); } while (0)
#define PG8_STAGE_A(bufoff, ptrexpr, U, KT, H) do { if constexpr (A_GATHER) { _Pragma("unroll") for (int _i = 0; _i < 2; ++_i) { \
        const unsigned e_ = *(const PG8_LAS unsigned short*)(lds + tadr[_i] + (U) * 512 + (H) * 256); \
        __builtin_amdgcn_global_load_lds((const unsigned*)((const char*)g.A + (size_t)(KT) * (BK * 2) + (e_ * (unsigned)(K * 2) + cg[_i])), (PG8_LAS unsigned*)(lds + (bufoff) + ldsw + _i * 8192), 16, 0, 0); } } \
    else PG8_STAGE(bufoff, ptrexpr, voffA); } while (0)
#define PG8_LDA(dst, b, h) do { _Pragma("unroll") for (int m = 0; m < 4; ++m) _Pragma("unroll") for (int k = 0; k < 2; ++k) dst[m][k] = *(const PG8_LAS bf16x8*)(lds + PG8_SA(b, h) + aoff + m * 2048 + k * 1024); } while (0)
#define PG8_LDB(dst, b, h) do { _Pragma("unroll") for (int n = 0; n < 2; ++n) _Pragma("unroll") for (int k = 0; k < 2; ++k) dst[n][k] = *(const PG8_LAS bf16x8*)(lds + PG8_SB(b, h) + boff + n * 2048 + k * 1024); } while (0)
#define PG8_MMA(ai, bj, At, Bt) do { __builtin_amdgcn_s_setprio(1); _Pragma("unroll") for (int m = 0; m < 4; ++m) _Pragma("unroll") for (int n = 0; n < 2; ++n) { \
        if constexpr (F8) { const i32x8 b8_ = cat8(Bt[n][0], Bt[n][1]), a8_ = cat8(At[m][0], At[m][1]); asm volatile("v_mfma_f32_16x16x128_f8f6f4 %0, %1, %2, %0" : "+v"(acc[ai][bj][m][n]) : "v"(b8_), "v"(a8_)); } \
        else { _Pragma("unroll") for (int k = 0; k < 2; ++k) acc[ai][bj][m][n] = __builtin_amdgcn_mfma_f32_16x16x32_bf16(Bt[n][k], At[m][k], acc[ai][bj][m][n], 0, 0, 0); } } __builtin_amdgcn_s_setprio(0); } while (0)
#define PG8_WAIT_V(n) asm volatile("s_waitcnt vmcnt(" #n ")" ::: "memory")
#define PG8_WAIT_VF(f, n) asm volatile("s_cmp_eq_u32 %0, 0\n\ts_cbranch_scc0 1f\n\ts_waitcnt vmcnt(8)\n1:\n\ts_waitcnt vmcnt(%1)" :: "s"(f), "n"(n) : "memory", "scc")
#define PG8_WAIT_L(n) asm volatile("s_waitcnt lgkmcnt(" #n ")" ::: "memory")
#define PG8_BAR __builtin_amdgcn_s_barrier()
#define PG8_SCHED __builtin_amdgcn_sched_barrier(0)
    if constexpr (A_GATHER) {
        Unit u_; for (int i = tid >> 8; S.next(i, u_); i += 2) *(PG8_LAS unsigned short*)(lds + g.tbl_off + (i * 256 + (tid & 255)) * 2) = (unsigned short)g.ridx[u_.pm * BM + (tid & 255)];
        __syncthreads();
    }
    Unit cur, nxt; int ui = 0;
    if (!S.next(0, cur)) return;
    f32x4 acc[2][2][4][2];
#pragma unroll
    for (int a = 0; a < 2; ++a)
#pragma unroll
        for (int b = 0; b < 2; ++b)
#pragma unroll
            for (int m = 0; m < 4; ++m)
#pragma unroll
                for (int n = 0; n < 2; ++n) acc[a][b][m][n] = (f32x4){0.f, 0.f, 0.f, 0.f};
    bf16x8 At[4][2], B0[2][2], B1[2][2];
    const char* cA = (const char*)g.A + (size_t)cur.pm * tstep; const char* cB = (const char*)g.Bt + (size_t)cur.pb * tstep;
    if constexpr (SP2) {
        PG8_STAGE(PG8_SB(0, 0), cB, voffB); PG8_STAGE(PG8_SB(0, 1), cB + hstepB, voffB); PG8_STAGE_A(PG8_SA(0, 0), cA, 0, 0, 0); PG8_STAGE_A(PG8_SA(0, 1), cA + hstepA, 0, 0, 1);
        if (wr == 1) PG8_BAR;
        PG8_WAIT_V(2); PG8_BAR;
        PG8_STAGE(PG8_SB(1, 0), cB + kstepB, voffB); PG8_STAGE_A(PG8_SA(1, 0), cA + kstepA, 0, 1, 0); PG8_STAGE(PG8_SB(1, 1), cB + hstepB + kstepB, voffB);
        PG8_WAIT_V(6); PG8_BAR;
    } else {
    PG8_STAGE(PG8_SB(0, 0), cB, voffB); PG8_STAGE(PG8_SA(0, 0), cA, voffA); PG8_STAGE(PG8_SB(0, 1), cB + hstepB, voffB); PG8_STAGE(PG8_SA(0, 1), cA + hstepA, voffA);
    if (wr == 1) PG8_BAR;
    PG8_WAIT_V(4); PG8_BAR;
    PG8_STAGE(PG8_SB(1, 0), cB + kstepB, voffB); PG8_STAGE(PG8_SA(1, 0), cA + kstepA, voffA); PG8_STAGE(PG8_SB(1, 1), cB + hstepB + kstepB, voffB);
    PG8_WAIT_V(6); PG8_BAR;
    }
    for (;;) {
        const bool has_next = S.next(ui + 1, nxt);
        const char* nA = has_next ? (const char*)g.A + (size_t)nxt.pm * tstep : cA; const char* nB = has_next ? (const char*)g.Bt + (size_t)nxt.pb * tstep : cB;
        for (int t = 0; t < nt; t += 2) {
            const bool last = (t == nt - 2);
            const int fst = __builtin_amdgcn_readfirstlane(((t == 0) && ui > 0) ? 1 : 0);
            const char* a1 = cA + (size_t)(t + 1) * kstepA;
            const char* a2 = last ? nA : cA + (size_t)(t + 2) * kstepA; const char* b2 = last ? nB : cB + (size_t)(t + 2) * kstepB;
            const char* a3 = a2 + kstepA; const char* b3 = b2 + kstepB;
            const int u2 = last ? (has_next ? ui + 1 : ui) : ui, k2 = last ? 0 : t + 2;
            if constexpr (SP2) {
            PG8_LDB(B0, 0, 0); PG8_LDB(B1, 0, 1); PG8_SCHED; PG8_LDA(At, 0, 0); PG8_STAGE_A(PG8_SA(1, 1), a1 + hstepA, ui, t + 1, 1);
            PG8_WAIT_VF(fst, 8 + Epi::NSTORE);
            PG8_WAIT_L(0); PG8_BAR; PG8_MMA(0, 0, At, B0); PG8_MMA(0, 1, At, B1); PG8_BAR; PG8_SCHED;
            PG8_LDA(At, 0, 1); PG8_STAGE(PG8_SB(0, 0), b2, voffB); PG8_STAGE(PG8_SB(0, 1), b2 + hstepB, voffB); PG8_STAGE_A(PG8_SA(0, 0), a2, u2, k2, 0);
            PG8_WAIT_VF(fst, 8 + Epi::NSTORE);
            PG8_WAIT_L(0); PG8_BAR; PG8_MMA(1, 0, At, B0); PG8_MMA(1, 1, At, B1); PG8_BAR; PG8_SCHED;
            PG8_LDB(B0, 1, 0); PG8_LDB(B1, 1, 1); PG8_SCHED; PG8_LDA(At, 1, 0); PG8_STAGE_A(PG8_SA(0, 1), a2 + hstepA, u2, k2, 1);
            PG8_WAIT_V(8); PG8_WAIT_L(0); PG8_BAR; PG8_MMA(0, 0, At, B0); PG8_MMA(0, 1, At, B1); PG8_BAR; PG8_SCHED;
            PG8_LDA(At, 1, 1); PG8_STAGE(PG8_SB(1, 0), b3, voffB); PG8_STAGE(PG8_SB(1, 1), b3 + hstepB, voffB); PG8_STAGE_A(PG8_SA(1, 0), a3, u2, k2 + 1, 0);
            PG8_WAIT_V(8); PG8_WAIT_L(0); PG8_BAR; PG8_MMA(1, 0, At, B0); PG8_MMA(1, 1, At, B1); PG8_BAR; PG8_SCHED;
            } else {
            PG8_LDB(B0, 0, 0); PG8_SCHED; PG8_LDA(At, 0, 0); PG8_STAGE(PG8_SA(1, 1), a1 + hstepA, voffA);
            PG8_WAIT_L(8); PG8_BAR; PG8_WAIT_L(0); PG8_MMA(0, 0, At, B0); PG8_BAR; PG8_SCHED;
            PG8_LDB(B1, 0, 1); PG8_STAGE(PG8_SB(0, 0), b2, voffB);
            PG8_BAR; PG8_WAIT_L(0); PG8_MMA(0, 1, At, B1); PG8_BAR;
            PG8_LDA(At, 0, 1); PG8_STAGE(PG8_SA(0, 0), a2, voffA);
            PG8_BAR; PG8_WAIT_L(0); PG8_MMA(1, 0, At, B0); PG8_BAR; PG8_SCHED;
            PG8_STAGE(PG8_SB(0, 1), b2 + hstepB, voffB);
            PG8_WAIT_V(6); PG8_BAR; PG8_MMA(1, 1, At, B1); PG8_BAR;
            PG8_LDB(B0, 1, 0); PG8_SCHED; PG8_LDA(At, 1, 0); PG8_STAGE(PG8_SA(0, 1), a2 + hstepA, voffA);
            PG8_WAIT_L(8); PG8_BAR; PG8_WAIT_L(0); PG8_MMA(0, 0, At, B0); PG8_BAR; PG8_SCHED;
            PG8_LDB(B1, 1, 1); PG8_STAGE(PG8_SB(1, 0), b3, voffB);
            PG8_BAR; PG8_WAIT_L(0); PG8_MMA(0, 1, At, B1); PG8_BAR;
            PG8_LDA(At, 1, 1); PG8_STAGE(PG8_SA(1, 0), a3, voffA);
            PG8_BAR; PG8_WAIT_L(0); PG8_MMA(1, 0, At, B0); PG8_BAR; PG8_SCHED;
            PG8_STAGE(PG8_SB(1, 1), b3 + hstepB, voffB);
            PG8_WAIT_V(6); PG8_BAR; PG8_MMA(1, 1, At, B1); PG8_BAR;
            }
        }
        if constexpr (ALIGN_EPI) { if (wr == 0) PG8_BAR; }
        if constexpr (F8) asm volatile("s_nop 15\n\ts_nop 15" ::: "memory");
        E(acc, cur, wr, wc, fr, fq);
        if (!has_next) break;
#pragma unroll
        for (int a = 0; a < 2; ++a)
#pragma unroll
            for (int b = 0; b < 2; ++b)
#pragma unroll
                for (int m = 0; m < 4; ++m)
#pragma unroll
                    for (int n = 0; n < 2; ++n) acc[a][b][m][n] = (f32x4){0.f, 0.f, 0.f, 0.f};
        cur = nxt; cA = nA; cB = nB; ++ui;
        if constexpr (ALIGN_EPI) { if (wr == 1) PG8_BAR; }
    }
    PG8_WAIT_V(0);
    if constexpr (!ALIGN_EPI) { if (wr == 0) PG8_BAR; }
    PG8_BAR;
#undef PG8_SA
#undef PG8_SB
#undef PG8_STAGE
#undef PG8_STAGE_A
#undef PG8_LDA
#undef PG8_LDB
#undef PG8_MMA
#undef PG8_WAIT_V
#undef PG8_WAIT_VF
#undef PG8_WAIT_L
#undef PG8_BAR
#undef PG8_SCHED
}
}
#include <string.h>
constexpr int MK_THREADS = 512;
constexpr float W1_SCALE = 32.0f, W2_SCALE = 64.0f, H_SCALE = 8.0f, LOG2E = 1.4426950408889634f;
constexpr int LDS_BYTES = 163840;
constexpr int MISC_OFF = LDS_BYTES - 1024;
constexpr int TBL_OFF = 131072, TBL_UNITS = (MISC_OFF - TBL_OFF) / 512;
constexpr size_t WS_CTL_BYTES = 1u << 20;
constexpr int CW_BAR = 4096;
constexpr int CW_QUEUE = 16384;
typedef unsigned short bf16;
typedef unsigned v4u __attribute__((ext_vector_type(4)));
#define GAS __attribute__((address_space(1)))
#define LDS_WAIT() asm volatile("s_waitcnt lgkmcnt(0)" ::: "memory")

__device__ __forceinline__ unsigned pk2(float lo, float hi) { unsigned r; asm volatile("v_cvt_pk_bf16_f32 %0, %1, %2" : "=v"(r) : "v"(lo), "v"(hi)); return r; }
#define BFLO(w) __builtin_bit_cast(float, (w) << 16)
#define BFHI(w) __builtin_bit_cast(float, (w) & 0xffff0000u)
__device__ __forceinline__ float bf2f(unsigned short b) { return __builtin_bit_cast(float, (unsigned)b << 16); }

__device__ __forceinline__ void p0_transpose_item(const float* W, int K, int N, bf16* WT, int mode, LAS float* scr, int item, int lane) {
    const int nblk = N / 32, kb = item / nblk, nb = item % nblk, k0 = 64 * kb, n0 = 32 * nb;
    const int r0 = mode == 0 ? n0 : (n0 / 128) * 256 + (n0 % 128) + (mode == 2 ? 128 : 0);
#pragma unroll 8
    for (int i = 0; i < 32; ++i) { const int kk = 2 * i + (lane >> 5); scr[kk * 33 + (lane & 31)] = __builtin_nontemporal_load(W + (size_t)(k0 + kk) * N + n0 + (lane & 31)); }
    LDS_WAIT(); asm volatile("" ::: "memory");
    const int c = lane & 7;
#pragma unroll
    for (int j = 0; j < 4; ++j) { const int n = (lane >> 3) + 8 * j; const LAS float* s = scr + (8 * c) * 33 + n;
        v4u o; o.x = pk2(s[0 * 33], s[1 * 33]); o.y = pk2(s[2 * 33], s[3 * 33]); o.z = pk2(s[4 * 33], s[5 * 33]); o.w = pk2(s[6 * 33], s[7 * 33]);
        *(GAS v4u*)(WT + (size_t)(r0 + n) * K + k0 + 8 * c) = o; }
    LDS_WAIT(); asm volatile("" ::: "memory");
}
__device__ __forceinline__ void conv_block_f8(const float* W, size_t src_stride, int nmat, int K, int N, unsigned char* WT, size_t dst_stride, int mode, float scale, LAS unsigned char* lds, int G) {
    int t_ = threadIdx.x; asm volatile("" : "+v"(t_)); const int tid0 = t_, wave = __builtin_amdgcn_readfirstlane(tid0 >> 6);
    LAS float* scr = (LAS float*)lds;
    const int nkb = K / 256, nnb = N / 64, per = nkb * nnb, total = nmat * per;
    pg8::f32x4 v[8];
#define CB_SRC(it_) (W + (size_t)((it_) / per) * src_stride + (size_t)(256 * (((it_) % per) / nnb)) * N + 64 * (((it_) % per) % nnb))
#define CB_LOAD(it_) do { const float* s_ = CB_SRC(it_); const int ln_ = tid0 & 63; _Pragma("unroll") for (int i = 0; i < 8; ++i) v[i] = __builtin_nontemporal_load((const pg8::f32x4*)(s_ + (size_t)(wave * 32 + i * 4 + (ln_ >> 4)) * N + (ln_ & 15) * 4));        } while (0)
    if ((int)blockIdx.x < total) CB_LOAD((int)blockIdx.x);
    for (int it = blockIdx.x; it < total; it += G) {
        int lane = tid0 & 63; asm volatile("" : "+v"(lane));
        const int mm = it / per, r = it % per, kb = r / nnb, nb = r % nnb, k0 = 256 * kb, n0 = 64 * nb;
        unsigned char* dst = WT + (size_t)mm * dst_stride;
        const int r0 = mode == 0 ? n0 : (n0 / 128) * 256 + (n0 % 128) + (mode == 2 ? 128 : 0);
        __syncthreads();
#pragma unroll
        for (int i = 0; i < 8; ++i) { const int kk = wave * 32 + i * 4 + (lane >> 4), c4 = (lane & 15) * 4; LAS float* q = scr + kk * 65 + c4; q[0] = v[i][0] * scale; q[1] = v[i][1] * scale; q[2] = v[i][2] * scale; q[3] = v[i][3] * scale; }
        __syncthreads();
        if (it + G < total) CB_LOAD(it + G);
#pragma unroll
        for (int i = 0; i < 2; ++i) { const int blk = wave * 2 + i, rg = blk >> 2, ktl = (blk >> 1) & 1, ch = blk & 1, R16 = lane & 15, pc = lane >> 4;
            const int Rl = rg * 16 + R16, nl = (Rl & ~31) + pg8::perm32(Rl & 31), kc = ktl * 128 + ch * 64 + pc * 16; const LAS float* s = scr + kc * 65 + nl;
            v4u o; o.x = pg8::pk4_fp8(s[0 * 65], s[1 * 65], s[2 * 65], s[3 * 65]); o.y = pg8::pk4_fp8(s[4 * 65], s[5 * 65], s[6 * 65], s[7 * 65]);
            o.z = pg8::pk4_fp8(s[8 * 65], s[9 * 65], s[10 * 65], s[11 * 65]); o.w = pg8::pk4_fp8(s[12 * 65], s[13 * 65], s[14 * 65], s[15 * 65]);
            const int R = (r0 & 127) + Rl;
            *(GAS v4u*)(dst + ((size_t)(r0 >> 8) * (K >> 7) + (k0 >> 7) + ktl) * 32768 + ((r0 >> 7) & 1) * 16384 + ((R >> 4) * 2 + ch) * 1024 + (((R & 15) * 64 + pc * 16) ^ ((R & 8) ? 32 : 0))) = o; }
    }
#undef CB_SRC
#undef CB_LOAD
    __syncthreads();
}
__device__ __forceinline__ void conv_ffn_dyn(const OP& p, int l, unsigned* qctr, LAS unsigned char* lds, int lo_, int nitems_) {
    const int LO = __builtin_amdgcn_readfirstlane(lo_), NIT = LO + __builtin_amdgcn_readfirstlane(nitems_);
    typedef Dims d;
    int t_ = threadIdx.x; asm volatile("" : "+v"(t_)); const int tid0 = t_, wave = __builtin_amdgcn_readfirstlane(tid0 >> 6);
    LAS float* scr = (LAS float*)lds; LAS int* slot = (LAS int*)(lds + MISC_OFF + 512);
    constexpr int PERM_ = 176, J = d::E * PERM_, TOTAL = 3 * J;
    static_assert((d::D / 256) * (d::FF / 64) == PERM_ && (d::FF / 256) * (d::D / 64) == PERM_, "item count");
    pg8::f32x4 v[8];
#define CD_LOAD(it_) do { const int job_ = (it_) / J, loc_ = (it_) - job_ * J, mm_ = loc_ / PERM_, r_ = loc_ - mm_ * PERM_, nnb_ = job_ == 2 ? d::D / 64 : d::FF / 64, kb_ = r_ / nnb_, nb_ = r_ - kb_ * nnb_, N_ = job_ == 2 ? d::D : d::FF; \
        const float* s_ = (job_ == 0 ? p.w_gate : (job_ == 1 ? p.w_up : p.w_down)) + ((size_t)l * d::E + mm_) * ((size_t)d::D * d::FF) + (size_t)(256 * kb_) * N_ + 64 * nb_; const int ln_ = tid0 & 63; \
        _Pragma("unroll") for (int i = 0; i < 8; ++i) v[i] = __builtin_nontemporal_load((const pg8::f32x4*)(s_ + (size_t)(wave * 32 + i * 4 + (ln_ >> 4)) * N_ + (ln_ & 15) * 4)); } while (0)
    unsigned pend = 0u;
    if (tid0 == 0) { slot[0] = (int)__hip_atomic_fetch_add(qctr, 1u, __ATOMIC_RELAXED, __HIP_MEMORY_SCOPE_AGENT); pend = __hip_atomic_fetch_add(qctr, 1u, __ATOMIC_RELAXED, __HIP_MEMORY_SCOPE_AGENT); }
    __syncthreads();
    int sf_ = MISC_OFF + 512; asm volatile("" : "+v"(sf_));
    int cur = LO + __builtin_amdgcn_readfirstlane(*(LAS int*)(lds + sf_));
    if (cur < NIT) CD_LOAD(cur);
    for (int k = 0; cur < NIT; ++k) {
        int lane = tid0 & 63; asm volatile("" : "+v"(lane));
        const int job = cur / J, loc = cur - job * J, mm = loc / PERM_, r = loc - mm * PERM_, nnb = job == 2 ? d::D / 64 : d::FF / 64, kb = r / nnb, nb = r - kb * nnb, k0 = 256 * kb, n0 = 64 * nb;
        const int K = job == 2 ? d::FF : d::D; const float scale = job == 2 ? W2_SCALE : W1_SCALE;
        unsigned char* dst = (unsigned char*)(job == 2 ? p.ffnW2 : p.ffnW1) + (size_t)mm * (job == 2 ? (size_t)d::D * d::FF : (size_t)2 * d::FF * d::D);
        const int r0 = job == 2 ? n0 : (n0 / 128) * 256 + (n0 % 128) + (job == 1 ? 128 : 0);
        __syncthreads();
        if (tid0 == 0) { slot[0] = (int)pend; pend = __hip_atomic_fetch_add(qctr, 1u, __ATOMIC_RELAXED, __HIP_MEMORY_SCOPE_AGENT); }
#pragma unroll
        for (int i = 0; i < 8; ++i) { const int kk = wave * 32 + i * 4 + (lane >> 4), c4 = (lane & 15) * 4; LAS float* q = scr + kk * 65 + c4; q[0] = v[i][0] * scale; q[1] = v[i][1] * scale; q[2] = v[i][2] * scale; q[3] = v[i][3] * scale; }
        __syncthreads();
        int so_ = MISC_OFF + 512; asm volatile("" : "+v"(so_));
        const int nxt = LO + __builtin_amdgcn_readfirstlane(*(LAS int*)(lds + so_));
        if (nxt < NIT) CD_LOAD(nxt);
#pragma unroll
        for (int i = 0; i < 2; ++i) { const int blk = wave * 2 + i, rg = blk >> 2, ktl = (blk >> 1) & 1, ch = blk & 1, R16 = lane & 15, pc = lane >> 4;
            const int Rl = rg * 16 + R16, nl = (Rl & ~31) + pg8::perm32(Rl & 31), kc = ktl * 128 + ch * 64 + pc * 16; const LAS float* sp = scr + kc * 65 + nl;
            v4u o; o.x = pg8::pk4_fp8(sp[0 * 65], sp[1 * 65], sp[2 * 65], sp[3 * 65]); o.y = pg8::pk4_fp8(sp[4 * 65], sp[5 * 65], sp[6 * 65], sp[7 * 65]);
            o.z = pg8::pk4_fp8(sp[8 * 65], sp[9 * 65], sp[10 * 65], sp[11 * 65]); o.w = pg8::pk4_fp8(sp[12 * 65], sp[13 * 65], sp[14 * 65], sp[15 * 65]);
            const int R = (r0 & 127) + Rl;
            *(GAS v4u*)(dst + ((size_t)(r0 >> 8) * (K >> 7) + (k0 >> 7) + ktl) * 32768 + ((r0 >> 7) & 1) * 16384 + ((R >> 4) * 2 + ch) * 1024 + (((R & 15) * 64 + pc * 16) ^ ((R & 8) ? 32 : 0))) = o; }
        cur = nxt;
    }
#undef CD_LOAD
    __syncthreads();
}
__device__ __forceinline__ void conv_group(const float* W, size_t src_stride, int nmat, int K, int N, bf16* WT, size_t dst_stride, int mode, LAS float* scr, int gw, int ngw, int lane) {
    const int per = (K / 64) * (N / 32), total = nmat * per;
    for (int it = gw; it < total; it += ngw) { const int m = it / per, r = it % per; p0_transpose_item(W + (size_t)m * src_stride, K, N, WT + (size_t)m * dst_stride, mode, scr, r, lane); }
}

typedef float f32x4v __attribute__((ext_vector_type(4)));
typedef unsigned u32x2v __attribute__((ext_vector_type(2)));
__device__ __forceinline__ float wave_sum(float v) {
#pragma unroll
    for (int o = 1; o < 64; o <<= 1) v += __shfl_xor(v, o);
    return v;
}
__device__ __forceinline__ float fast_silu(float x) { return x * __builtin_amdgcn_rcpf(1.0f + __expf(-x)); }

__device__ __forceinline__ void phase_mod(const OP& p, LAS unsigned char* lds, int G) {
    typedef Dims d; constexpr int D6 = 6 * d::D, NS = d::B + 1, NU = d::DEPTH * (D6 / 64);
    int t_ = threadIdx.x; asm volatile("" : "+v"(t_)); const int tid = t_, lane = tid & 63, wave = __builtin_amdgcn_readfirstlane(tid >> 6);
    LAS float* sc = (LAS float*)lds;
    LAS float* red = (LAS float*)(lds + NS * d::D * 4);
    for (int i = tid; i < NS * d::D; i += MK_THREADS) { const int s = i / d::D, k = i % d::D; const float v = s < d::B ? p.c[(size_t)s * d::D + k] : p.c_ctx[k]; sc[i] = v / (1.0f + expf(-v)); }
    __syncthreads();
    for (int u = blockIdx.x; u < NU; u += G) {
        const int l = u / (D6 / 64), cb = u % (D6 / 64), col = cb * 64 + lane;
        const float* w = p.w_mod + (size_t)l * d::D * D6 + col;
        float acc[NS];
#pragma unroll
        for (int s = 0; s < NS; ++s) acc[s] = 0.f;
        const int k0 = wave * (d::D / 8);
        for (int kb = k0; kb < k0 + d::D / 8; kb += 16) {
            float wv[16];
#pragma unroll
            for (int i = 0; i < 16; ++i) wv[i] = __builtin_nontemporal_load(w + (size_t)(kb + i) * D6);
#pragma unroll
            for (int i = 0; i < 16; ++i) {
#pragma unroll
                for (int s = 0; s < NS; ++s) acc[s] += sc[s * d::D + kb + i] * wv[i]; } }
#pragma unroll
        for (int s = 0; s < NS; ++s) red[(wave * NS + s) * 64 + lane] = acc[s];
        __syncthreads();
        for (int i = tid; i < NS * 64; i += MK_THREADS) { const int s = i / 64, cl = i % 64; float v = 0.f;
#pragma unroll
            for (int wv = 0; wv < 8; ++wv) v += red[(wv * NS + s) * 64 + cl];
            p.mod[((size_t)l * NS + s) * D6 + cb * 64 + cl] = v + p.b_mod[(size_t)l * D6 + cb * 64 + cl]; }
        __syncthreads();
    }
}

template <int MODE>
__device__ __forceinline__ void phase_rows(const OP& p, LAS unsigned char* lds, int G, const float* src, const float* src2, int nrows, int lc, int ln, int which) {
    typedef Dims d;
    int t_ = threadIdx.x; asm volatile("" : "+v"(t_)); const int tid = t_, lane = tid & 63, wave = __builtin_amdgcn_readfirstlane(tid >> 6);
    LAS float* wr = (LAS float*)lds;
    if (MODE & 16) {
        const float* w = p.w_router + (size_t)ln * d::D * d::E;
        for (int i = tid; i < d::D * d::E; i += MK_THREADS) { const int k = i / d::E, e = i % d::E; wr[e * d::D + k] = w[i]; }
        __syncthreads();
    }
    const int gw = blockIdx.x * 8 + wave, ngw = G * 8, rpw = (nrows + ngw - 1) / ngw;
    const int rbeg = gw * rpw, rend = (rbeg + rpw < nrows) ? rbeg + rpw : nrows;
    if (rbeg >= rend) return;
#define ROW_PTR(r) ((r) < d::NL ? src + (size_t)(r) * d::D : src2 + (size_t)((r) - d::NL) * d::D)
    f32x4v xn[4];
#pragma unroll
    for (int j = 0; j < 4; ++j) xn[j] = *(const f32x4v*)(ROW_PTR(rbeg) + 4 * lane + 256 * j);
    int mcur = -1; f32x4v gv[4], sh[4], sc1[4], gt[4];
    for (int r = rbeg; r < rend; ++r) {
        const int mi = r < d::NL ? r / d::S : d::B;
        f32x4v x[4];
#pragma unroll
        for (int j = 0; j < 4; ++j) x[j] = xn[j];
        if (r + 1 < rend) {
#pragma unroll
            for (int j = 0; j < 4; ++j) xn[j] = *(const f32x4v*)(ROW_PTR(r + 1) + 4 * lane + 256 * j); }
        if (mi != mcur) {
            mcur = mi;
            if (MODE & 8) { const float* g = (which ? p.g_ffn : p.g_mix) + (size_t)ln * d::D + 4 * lane; const float* mm = p.mod + ((size_t)ln * (d::B + 1) + mi) * 6 * d::D + 4 * lane;
#pragma unroll
                for (int j = 0; j < 4; ++j) { gv[j] = *(const f32x4v*)(g + 256 * j); sh[j] = *(const f32x4v*)(mm + (which ? 3 : 0) * d::D + 256 * j); sc1[j] = *(const f32x4v*)(mm + (which ? 4 : 1) * d::D + 256 * j) + 1.0f; } }
            if (MODE & 1) { const float* gp = p.mod + ((size_t)lc * (d::B + 1) + mi) * 6 * d::D + 5 * d::D + 4 * lane;
#pragma unroll
                for (int j = 0; j < 4; ++j) gt[j] = *(const f32x4v*)(gp + 256 * j); }
        }
        if (MODE & 1) {
            f32x4v s[4];
#pragma unroll
            for (int j = 0; j < 4; ++j) s[j] = (f32x4v){0.f, 0.f, 0.f, 0.f};
            const int mysl = lane < d::E ? p.slotof[(size_t)r * d::E + lane] : -1;
            for (int e = 0; e < d::E; ++e) { const int sl = __builtin_amdgcn_readlane(mysl, e); if (sl < 0) continue;
                const bf16* yr = p.ybufb + (size_t)sl * d::D + 4 * lane;
#pragma unroll
                for (int j = 0; j < 4; ++j) { const u32x2v w2 = (MODE & 4) ? __builtin_nontemporal_load((const u32x2v*)(yr + 256 * j)) : *(const u32x2v*)(yr + 256 * j); s[j] += (f32x4v){BFLO(w2.x), BFHI(w2.x), BFLO(w2.y), BFHI(w2.y)}; } }
#pragma unroll
            for (int j = 0; j < 4; ++j) x[j] += gt[j] * s[j];
        }
        if (MODE & 2) {
#pragma unroll
            for (int j = 0; j < 4; ++j) *(f32x4v*)(p.xcur + (size_t)r * d::D + 4 * lane + 256 * j) = x[j]; }
        if (MODE & 4) { if (r < d::NL) {
#pragma unroll
            for (int j = 0; j < 4; ++j) __builtin_nontemporal_store(x[j], (f32x4v*)(p.out + (size_t)r * d::D + 4 * lane + 256 * j)); } }
        if (MODE & 8) {
            float ss = 0.f;
#pragma unroll
            for (int j = 0; j < 4; ++j) ss += (x[j].x * x[j].x + x[j].y * x[j].y) + (x[j].z * x[j].z + x[j].w * x[j].w);
            const float rs = 1.0f / sqrtf(wave_sum(ss) * (1.0f / d::D) + 1e-6f);
            f32x4v h[4];
#pragma unroll
            for (int j = 0; j < 4; ++j) { h[j] = x[j] * rs * gv[j] * sc1[j] + sh[j];
                if (MODE & 16) *(unsigned*)((unsigned char*)p.hbf + (size_t)r * d::D + 4 * lane + 256 * j) = pg8::pk4_fp8(h[j].x, h[j].y, h[j].z, h[j].w);
                else { u32x2v o; o.x = pk2(h[j].x, h[j].y); o.y = pk2(h[j].z, h[j].w); *(u32x2v*)(p.hbf + (size_t)r * d::D + 4 * lane + 256 * j) = o; } }
            if (MODE & 16) {
                float lg[16]; int wo = 4 * lane; asm volatile("" : "+v"(wo));
#pragma unroll
                for (int e = 0; e < 16; ++e) { float a = 0.f;
#pragma unroll
                    for (int j = 0; j < 4; ++j) { const f32x4v wv = *(const LAS f32x4v*)(wr + e * d::D + wo + 256 * j); a += (h[j].x * wv.x + h[j].y * wv.y) + (h[j].z * wv.z + h[j].w * wv.w); }
                    lg[e] = a; }
                float v8[8], v4[4], v2[2], v1;
                { const bool hi = (lane & 32) != 0;
#pragma unroll
                  for (int i = 0; i < 8; ++i) { const float mine = hi ? lg[8 + i] : lg[i], theirs = hi ? lg[i] : lg[8 + i]; v8[i] = mine + __shfl_xor(theirs, 32); } }
                { const bool hi = (lane & 16) != 0;
#pragma unroll
                  for (int i = 0; i < 4; ++i) { const float mine = hi ? v8[4 + i] : v8[i], theirs = hi ? v8[i] : v8[4 + i]; v4[i] = mine + __shfl_xor(theirs, 16); } }
                { const bool hi = (lane & 8) != 0;
#pragma unroll
                  for (int i = 0; i < 2; ++i) { const float mine = hi ? v4[2 + i] : v4[i], theirs = hi ? v4[i] : v4[2 + i]; v2[i] = mine + __shfl_xor(theirs, 8); } }
                { const bool hi = (lane & 4) != 0; const float mine = hi ? v2[1] : v2[0], theirs = hi ? v2[0] : v2[1]; v1 = mine + __shfl_xor(theirs, 4); }
                v1 += __shfl_xor(v1, 1); v1 += __shfl_xor(v1, 2);
                float mx = v1;
#pragma unroll
                for (int o = 4; o < 64; o <<= 1) mx = fmaxf(mx, __shfl_xor(mx, o));
                const float ev = expf(v1 - mx); float sum = ev;
#pragma unroll
                for (int o = 4; o < 64; o <<= 1) sum += __shfl_xor(sum, o);
                const int e = ((lane >> 5) & 1) * 8 + ((lane >> 4) & 1) * 4 + ((lane >> 3) & 1) * 2 + ((lane >> 2) & 1);
                if ((lane & 3) == 0) p.aff[(size_t)r * d::E + e] = ev / sum;
            }
        }
    }
#undef ROW_PTR
}

__device__ __forceinline__ void router_finish(const float (&lg)[16], int lane, float* affrow) {
    float v8[8], v4[4], v2[2], v1;
    { const bool hi = (lane & 32) != 0;
#pragma unroll
      for (int i = 0; i < 8; ++i) { const float mine = hi ? lg[8 + i] : lg[i], theirs = hi ? lg[i] : lg[8 + i]; v8[i] = mine + __shfl_xor(theirs, 32); } }
    { const bool hi = (lane & 16) != 0;
#pragma unroll
      for (int i = 0; i < 4; ++i) { const float mine = hi ? v8[4 + i] : v8[i], theirs = hi ? v8[i] : v8[4 + i]; v4[i] = mine + __shfl_xor(theirs, 16); } }
    { const bool hi = (lane & 8) != 0;
#pragma unroll
      for (int i = 0; i < 2; ++i) { const float mine = hi ? v4[2 + i] : v4[i], theirs = hi ? v4[i] : v4[2 + i]; v2[i] = mine + __shfl_xor(theirs, 8); } }
    { const bool hi = (lane & 4) != 0; const float mine = hi ? v2[1] : v2[0], theirs = hi ? v2[0] : v2[1]; v1 = mine + __shfl_xor(theirs, 4); }
    v1 += __shfl_xor(v1, 1); v1 += __shfl_xor(v1, 2);
    float mx = v1;
#pragma unroll
    for (int o = 4; o < 64; o <<= 1) mx = fmaxf(mx, __shfl_xor(mx, o));
    const float ev = expf(v1 - mx); float sum = ev;
#pragma unroll
    for (int o = 4; o < 64; o <<= 1) sum += __shfl_xor(sum, o);
    const int e = ((lane >> 5) & 1) * 8 + ((lane >> 4) & 1) * 4 + ((lane >> 3) & 1) * 2 + ((lane >> 2) & 1);
    if ((lane & 3) == 0) affrow[e] = ev / sum;
}
constexpr int RT_P = 1028;
constexpr int RT_WT = 0, RT_HB = 16 * RT_P * 4, RT_PART = 2 * 16 * RT_P * 4;
__device__ __forceinline__ void phase_router(const OP& p, LAS unsigned char* lds, int G, const float* src, const float* src2, int nrows, int ln) {
    typedef Dims d;
    int t_ = threadIdx.x; asm volatile("" : "+v"(t_)); const int tid = t_, lane = tid & 63, wave = __builtin_amdgcn_readfirstlane(tid >> 6);
    LAS float* wt = (LAS float*)(lds + RT_WT); LAS float* hb = (LAS float*)(lds + RT_HB); LAS float* part = (LAS float*)(lds + RT_PART);
    { const f32x4v* w4 = (const f32x4v*)(p.w_router + (size_t)ln * d::D * d::E); f32x4v wv[8];
#pragma unroll
      for (int q = 0; q < 8; ++q) wv[q] = w4[tid + MK_THREADS * q];
#pragma unroll
      for (int q = 0; q < 8; ++q) { const int i4 = tid + MK_THREADS * q, k = i4 >> 2, e0 = (i4 & 3) * 4; wt[(e0 + 0) * RT_P + k] = wv[q].x; wt[(e0 + 1) * RT_P + k] = wv[q].y; wt[(e0 + 2) * RT_P + k] = wv[q].z; wt[(e0 + 3) * RT_P + k] = wv[q].w; } }
    __syncthreads();
    const int nblk = nrows / 16;
#define ROW_PTR(r) ((r) < d::NL ? src + (size_t)(r) * d::D : src2 + (size_t)((r) - d::NL) * d::D)
    f32x4v xn[2][4];
    if ((int)blockIdx.x < nblk) {
#pragma unroll
        for (int q = 0; q < 2; ++q)
#pragma unroll
            for (int j = 0; j < 4; ++j) xn[q][j] = *(const f32x4v*)(ROW_PTR(16 * (int)blockIdx.x + 2 * wave + q) + 4 * lane + 256 * j); }
    int mcur = -1; f32x4v gs[4], sh[4];
    for (int bi = blockIdx.x; bi < nblk; bi += G) {
        int lo_ = lane; asm volatile("" : "+v"(lo_));
        const int r = 16 * bi + 2 * wave, mi = r < d::NL ? r / d::S : d::B;
        f32x4v x[2][4];
#pragma unroll
        for (int q = 0; q < 2; ++q)
#pragma unroll
            for (int j = 0; j < 4; ++j) x[q][j] = xn[q][j];
        if (bi + G < nblk) {
#pragma unroll
            for (int q = 0; q < 2; ++q)
#pragma unroll
                for (int j = 0; j < 4; ++j) xn[q][j] = *(const f32x4v*)(ROW_PTR(16 * (bi + G) + 2 * wave + q) + 4 * lo_ + 256 * j); }
        if (mi != mcur) {
            mcur = mi; const float* g = p.g_ffn + (size_t)ln * d::D + 4 * lo_; const float* mm = p.mod + ((size_t)ln * (d::B + 1) + mi) * 6 * d::D + 4 * lo_;
#pragma unroll
            for (int j = 0; j < 4; ++j) { gs[j] = *(const f32x4v*)(g + 256 * j) * (*(const f32x4v*)(mm + 4 * d::D + 256 * j) + 1.0f); sh[j] = *(const f32x4v*)(mm + 3 * d::D + 256 * j); } }
        {
            float ssA = 0.f, ssB = 0.f;
#pragma unroll
            for (int j = 0; j < 4; ++j) { ssA += (x[0][j].x * x[0][j].x + x[0][j].y * x[0][j].y) + (x[0][j].z * x[0][j].z + x[0][j].w * x[0][j].w);
                                          ssB += (x[1][j].x * x[1][j].x + x[1][j].y * x[1][j].y) + (x[1][j].z * x[1][j].z + x[1][j].w * x[1][j].w); }
            const float rsA = 1.0f / sqrtf(wave_sum(ssA) * (1.0f / d::D) + 1e-6f), rsB = 1.0f / sqrtf(wave_sum(ssB) * (1.0f / d::D) + 1e-6f);
#pragma unroll
            for (int j = 0; j < 4; ++j) { const f32x4v hA = x[0][j] * rsA * gs[j] + sh[j], hB = x[1][j] * rsB * gs[j] + sh[j];
                *(unsigned*)((unsigned char*)p.hbf + (size_t)r * d::D + 4 * lo_ + 256 * j) = pg8::pk4_fp8(hA.x, hA.y, hA.z, hA.w);
                *(unsigned*)((unsigned char*)p.hbf + (size_t)(r + 1) * d::D + 4 * lo_ + 256 * j) = pg8::pk4_fp8(hB.x, hB.y, hB.z, hB.w);
                *(LAS f32x4v*)(hb + (2 * wave) * RT_P + 4 * lo_ + 256 * j) = hA; *(LAS f32x4v*)(hb + (2 * wave + 1) * RT_P + 4 * lo_ + 256 * j) = hB; }
        }
        __syncthreads();
        {
            const LAS float* ap = hb + (lo_ & 15) * RT_P + 128 * wave + 32 * (lo_ >> 4); const LAS float* bp = wt + (lo_ & 15) * RT_P + 128 * wave + 32 * (lo_ >> 4);
            pg8::f32x4 acc = (pg8::f32x4){0.f, 0.f, 0.f, 0.f};
#pragma unroll
            for (int t4 = 0; t4 < 8; ++t4) { const f32x4v a4 = *(const LAS f32x4v*)(ap + 4 * t4), b4 = *(const LAS f32x4v*)(bp + 4 * t4);
                acc = __builtin_amdgcn_mfma_f32_16x16x4f32(a4.x, b4.x, acc, 0, 0, 0); acc = __builtin_amdgcn_mfma_f32_16x16x4f32(a4.y, b4.y, acc, 0, 0, 0);
                acc = __builtin_amdgcn_mfma_f32_16x16x4f32(a4.z, b4.z, acc, 0, 0, 0); acc = __builtin_amdgcn_mfma_f32_16x16x4f32(a4.w, b4.w, acc, 0, 0, 0); }
#pragma unroll
            for (int rr = 0; rr < 4; ++rr) part[wave * 256 + (4 * (lo_ >> 4) + rr) * 16 + (lo_ & 15)] = acc[rr];
        }
        __syncthreads();
        if (tid < 256) {
            float v = 0.f;
#pragma unroll
            for (int w8 = 0; w8 < 8; ++w8) v += part[w8 * 256 + tid];
            float mx = v;
#pragma unroll
            for (int o = 1; o < 16; o <<= 1) mx = fmaxf(mx, __shfl_xor(mx, o));
            const float ev = expf(v - mx); float sum = ev;
#pragma unroll
            for (int o = 1; o < 16; o <<= 1) sum += __shfl_xor(sum, o);
            p.aff[(size_t)(16 * bi) * d::E + tid] = ev / sum;
        }
    }
#undef ROW_PTR
    __syncthreads();
}

__device__ __forceinline__ void phase_topk(const OP& p, LAS unsigned char* lds, int G, bool with_ctx) {
    typedef Dims d;
    int t_ = threadIdx.x; asm volatile("" : "+v"(t_)); const int tid = t_, lane = tid & 63, wave = __builtin_amdgcn_readfirstlane(tid >> 6);
    LAS unsigned* keys = (LAS unsigned*)lds;
    LAS unsigned* hist = (LAS unsigned*)(lds + 8192);
    LAS int* sel = (LAS int*)(lds + 8192 + 1024);
    LAS unsigned* scal = (LAS unsigned*)(lds + 8192 + 2048);
    const int NU = d::B * d::E * (with_ctx ? 2 : 1);
    for (int u = blockIdx.x; u < NU; u += G) {
        const int kind = u >= d::B * d::E ? 1 : 0, ue = u % (d::B * d::E), e = ue / d::B, b = ue % d::B;
        const int L = kind ? d::C : d::S, cap = kind ? d::capC : d::capL, r0 = kind ? d::NL + b * d::C : b * d::S;
        __syncthreads();
        for (int t = tid; t < L; t += MK_THREADS) keys[t] = __builtin_bit_cast(unsigned, p.aff[(size_t)(r0 + t) * d::E + e]);
        __syncthreads();
        const bool valid = 4 * tid < L; unsigned k[4];
#pragma unroll
        for (int i = 0; i < 4; ++i) k[i] = valid ? keys[4 * tid + i] : 0u;
        unsigned prefix = 0u, remaining = (unsigned)cap;
        for (int pass = 0; pass < 4; ++pass) {
            const int shift = 24 - 8 * pass;
            if (tid < 256) hist[tid] = 0u;
            __syncthreads();
            if (valid) {
#pragma unroll
                for (int i = 0; i < 4; ++i) if (pass == 0 || (k[i] >> (shift + 8)) == (prefix >> (shift + 8))) __hip_atomic_fetch_add(&hist[(k[i] >> shift) & 255u], 1u, __ATOMIC_RELAXED, __HIP_MEMORY_SCOPE_WORKGROUP); }
            __syncthreads();
            if (wave == 0) {
                unsigned c4[4]; unsigned s = 0u;
#pragma unroll
                for (int j = 0; j < 4; ++j) { c4[j] = hist[4 * lane + j]; s += c4[j]; }
                unsigned incl = s;
#pragma unroll
                for (int o = 1; o < 64; o <<= 1) { const unsigned t = __shfl_down(incl, o); if (lane + o < 64) incl += t; }
                const unsigned excl = incl - s;
                if (excl < remaining && remaining <= incl) { unsigned cum = excl; int bin = 4 * lane; unsigned nr = remaining;
#pragma unroll
                    for (int j = 3; j >= 0; --j) { if (cum + c4[j] >= remaining) { bin = 4 * lane + j; nr = remaining - cum; break; } cum += c4[j]; }
                    scal[0] = (unsigned)bin; scal[1] = nr; }
            }
            __syncthreads();
            prefix |= scal[0] << shift; remaining = scal[1];
        }
        unsigned cnt = 0u;
#pragma unroll
        for (int i = 0; i < 4; ++i) if (valid) cnt += (k[i] > prefix ? 1u : 0u) + (k[i] == prefix ? 0x10000u : 0u);
        unsigned inc = cnt;
#pragma unroll
        for (int o = 1; o < 64; o <<= 1) { const unsigned t = __shfl_up(inc, o); if (lane >= o) inc += t; }
        if (lane == 63) scal[8 + wave] = inc;
        __syncthreads();
        unsigned base = inc - cnt;
        for (int w = 0; w < wave; ++w) base += scal[8 + w];
        unsigned gpos = base & 0xffffu, epos = base >> 16; const unsigned ngt = (unsigned)cap - remaining;
        const int slot0 = (kind ? d::NSL : 0) + (e * d::B + b) * cap;
        if (valid) {
#pragma unroll
            for (int i = 0; i < 4; ++i) { const int row = r0 + 4 * tid + i; int slot = -1;
                if (k[i] > prefix) { slot = slot0 + (int)gpos; ++gpos; }
                else if (k[i] == prefix) { if (epos < remaining) slot = slot0 + (int)(ngt + epos); ++epos; }
                p.slotof[(size_t)row * d::E + e] = slot;
                if (slot >= 0) { p.rowidx[slot] = row; p.gate[slot] = __builtin_bit_cast(float, k[i]); } }
        }
        __syncthreads();
    }
    __syncthreads();
}

typedef short bf16x8v __attribute__((ext_vector_type(8)));
typedef float f32x16v __attribute__((ext_vector_type(16)));
#define MFMA32(a, b, c) __builtin_amdgcn_mfma_f32_32x32x16_bf16((a), (b), (c), 0, 0, 0)
__device__ __forceinline__ unsigned cvtpk(float lo, float hi) { unsigned r; asm volatile("v_cvt_pk_bf16_f32 %0, %1, %2" : "=v"(r) : "v"(lo), "v"(hi)); return r; }
__device__ __forceinline__ float xhalf_max(float x) { float a = x, b = x; asm volatile("s_nop 1\n\tv_permlane32_swap_b32 %0, %1" : "+v"(a), "+v"(b)); return fmaxf(a, b); }
__device__ __forceinline__ float xhalf_sum(float x) { float a = x, b = x; asm volatile("s_nop 1\n\tv_permlane32_swap_b32 %0, %1" : "+v"(a), "+v"(b)); return a + b; }
__device__ __forceinline__ int crow32(int reg, int hh) { return (reg & 3) + 8 * (reg >> 2) + 4 * hh; }

struct PrepBufs {
    bf16 *qb, *kb;
    bf16 *vTl, *vTc;
    bf16 *rqb, *rkb;
    bf16 *rkTl, *rkTc, *rvTl, *rvTc;
    bf16 *hglu;
    bf16 *sprevT;
};

constexpr int PREP_LP = 144, PREP_WL = 64 * PREP_LP;
__device__ __forceinline__ void load64(const bf16* u, int r0, int c0, LAS unsigned char* wl, int lane, float (&v)[64]) {
    v4u t[8];
#pragma unroll
    for (int i = 0; i < 8; ++i) t[i] = *(const v4u*)(u + (size_t)(r0 + 8 * i + (lane >> 3)) * Dims::INC + c0 + (lane & 7) * 8);
#pragma unroll
    for (int i = 0; i < 8; ++i) *(LAS v4u*)(wl + (8 * i + (lane >> 3)) * PREP_LP + (lane & 7) * 16) = t[i];
#pragma unroll
    for (int i = 0; i < 8; ++i) { const v4u w = *(const LAS v4u*)(wl + lane * PREP_LP + i * 16);
        v[8 * i] = BFLO(w.x); v[8 * i + 1] = BFHI(w.x); v[8 * i + 2] = BFLO(w.y); v[8 * i + 3] = BFHI(w.y); v[8 * i + 4] = BFLO(w.z); v[8 * i + 5] = BFHI(w.z); v[8 * i + 6] = BFLO(w.w); v[8 * i + 7] = BFHI(w.w); }
}
__device__ __forceinline__ void store64_row(bf16* dst0, int pitch, LAS unsigned char* wl, int lane, const float (&v)[64]) {
#pragma unroll
    for (int i = 0; i < 8; ++i) { v4u o; o.x = cvtpk(v[8 * i], v[8 * i + 1]); o.y = cvtpk(v[8 * i + 2], v[8 * i + 3]); o.z = cvtpk(v[8 * i + 4], v[8 * i + 5]); o.w = cvtpk(v[8 * i + 6], v[8 * i + 7]); *(LAS v4u*)(wl + lane * PREP_LP + i * 16) = o; }
#pragma unroll
    for (int i = 0; i < 8; ++i) { const v4u w = *(const LAS v4u*)(wl + (8 * i + (lane >> 3)) * PREP_LP + (lane & 7) * 16); *(v4u*)(dst0 + (size_t)(8 * i + (lane >> 3)) * pitch + (lane & 7) * 8) = w; }
}
__device__ __forceinline__ void store64_T(bf16* dst, int pitch, const float (&v)[64]) {
#pragma unroll
    for (int dd = 0; dd < 64; dd += 2) { const unsigned w = pk2(v[dd], v[dd + 1]); dst[(size_t)dd * pitch] = (bf16)(w & 0xffffu); dst[(size_t)(dd + 1) * pitch] = (bf16)(w >> 16); }
}
__device__ __forceinline__ void fast_sincos(float x, float* sn, float* cs) { float r = x * 0.15915494309189535f; r = r - floorf(r); *sn = __builtin_amdgcn_sinf(r); *cs = __builtin_amdgcn_cosf(r); }
template <int ITEMS>
__device__ __forceinline__ void phase_prep(const OP& p, const PrepBufs& pb, LAS unsigned char* lds, int G, int l, bool last) {
    typedef Dims d; const bf16* ub = (const bf16*)p.u;
    int t_ = threadIdx.x; asm volatile("" : "+v"(t_)); const int tid = t_, lane = tid & 63, wave = __builtin_amdgcn_readfirstlane(tid >> 6);
    constexpr int NU = d::NR / 64; LAS unsigned char* wl = lds + wave * PREP_WL;
    for (int wi = blockIdx.x * 8 + wave; wi < NU * 28; wi += G * 8) {
        const int u = wi / 28, it = wi % 28;
        const int r0 = u * 64; const int kind = r0 >= d::NL ? 1 : 0;
        const int b = kind ? (r0 - d::NL) / d::C : r0 / d::S, t0 = kind ? (r0 - d::NL) % d::C : r0 % d::S, L = kind ? d::C : d::S;
        {
            int lo_ = lane; asm volatile("" : "+v"(lo_)); const int r = r0 + lo_, t = t0 + lo_;
            float v[64];
            if (it < 10) {
                if (!(ITEMS & 1)) continue;
                const bool isq = it < 8; const int hi = isq ? it : it - 8;
                if (kind == 1 && last && isq) continue;
                load64(ub, r0, (isq ? d::oAQ : d::oAK) + hi * 64, wl, lo_, v);
                const float* g = (isq ? p.q_norm_g : p.k_norm_g) + (size_t)l * 64;
                float ss = 0.f;
#pragma unroll
                for (int k = 0; k < 64; ++k) ss += v[k] * v[k];
                const float rs = 1.0f / sqrtf(ss * (1.0f / 64.0f) + 1e-6f);
#pragma unroll
                for (int k = 0; k < 64; ++k) v[k] = v[k] * rs * g[k];
                if (kind == 0) {
                    const float prow = (float)(t / d::GRID_W), pcol = (float)(t % d::GRID_W);
#pragma unroll
                    for (int j = 0; j < 16; ++j) { const float inv = exp2f(-(float)j * (13.287712379549449f / 16.0f));
                        float sn, cs; fast_sincos(prow * inv, &sn, &cs); { const float x1 = v[j], x2 = v[j + 16]; v[j] = x1 * cs - x2 * sn; v[j + 16] = x1 * sn + x2 * cs; }
                        fast_sincos(pcol * inv, &sn, &cs); { const float x1 = v[32 + j], x2 = v[48 + j]; v[32 + j] = x1 * cs - x2 * sn; v[48 + j] = x1 * sn + x2 * cs; } }
                }
                store64_row(isq ? pb.qb + (size_t)r0 * d::AW + hi * 64 : pb.kb + (size_t)r0 * d::KVW + hi * 64, isq ? d::AW : d::KVW, wl, lo_, v);
            } else if (it < 12) {
                if (!(ITEMS & 1)) continue;
                const int hi = it - 10; load64(ub, r0, d::oAV + hi * 64, wl, lo_, v);
                store64_T((kind ? pb.vTc + ((size_t)(b * d::KVH + hi) * 64) * d::C : pb.vTl + ((size_t)(b * d::KVH + hi) * 64) * d::S) + t, L, v);
            } else if (it < 20) {
                if (!(ITEMS & 2)) continue;
                const bool isq = it < 16; const int hi = isq ? it - 12 : it - 16;
                if (kind == 1 && last && isq) continue;
                load64(ub, r0, (isq ? d::oRQ : d::oRK) + hi * 64, wl, lo_, v);
                const float pos = (float)(kind ? t : d::C + t), sc = isq ? 1.0f : 0.125f;
#pragma unroll
                for (int j = 0; j < 32; ++j) { const float inv = exp2f(-(float)j * (13.287712379549449f / 32.0f)); float sn, cs; fast_sincos(pos * inv, &sn, &cs);
                    const float x1 = v[j], x2 = v[j + 32]; v[j] = (x1 * cs - x2 * sn) * sc; v[j + 32] = (x1 * sn + x2 * cs) * sc; }
                store64_row((isq ? pb.rqb : pb.rkb) + (size_t)r0 * d::RW + hi * 64, d::RW, wl, lo_, v);
                if (!isq) store64_T((kind ? pb.rkTc + ((size_t)(b * d::RH + hi) * 64) * d::C : pb.rkTl + ((size_t)(b * d::RH + hi) * 64) * d::S) + t, L, v);
            } else if (it < 24) {
                if (!(ITEMS & 2)) continue;
                const int hi = it - 20; load64(ub, r0, d::oRV + hi * 64, wl, lo_, v);
                store64_T((kind ? pb.rvTc + ((size_t)(b * d::RH + hi) * 64) * d::C : pb.rvTl + ((size_t)(b * d::RH + hi) * 64) * d::S) + t, L, v);
            } else {
                if (!(ITEMS & 4)) continue;
                if (kind == 1 && last) continue;
                const int c0 = (it - 24) * 64;
#pragma unroll
                for (int i = 0; i < 8; ++i) { const size_t row = (size_t)(r0 + 8 * i + (lo_ >> 3)); const int cc = c0 + (lo_ & 7) * 8;
                    const v4u a = *(const v4u*)(ub + row * d::INC + d::oCV + cc), g4 = *(const v4u*)(ub + row * d::INC + d::oCV + d::CW + cc); v4u o;
#define GLU_(av, gv) ((av) * __builtin_amdgcn_rcpf(1.0f + __expf(-(gv))))
                    o.x = cvtpk(GLU_(BFLO(a.x), BFLO(g4.x)), GLU_(BFHI(a.x), BFHI(g4.x))); o.y = cvtpk(GLU_(BFLO(a.y), BFLO(g4.y)), GLU_(BFHI(a.y), BFHI(g4.y)));
                    o.z = cvtpk(GLU_(BFLO(a.z), BFLO(g4.z)), GLU_(BFHI(a.z), BFHI(g4.z))); o.w = cvtpk(GLU_(BFLO(a.w), BFLO(g4.w)), GLU_(BFHI(a.w), BFHI(g4.w)));
#undef GLU_
                    *(v4u*)(pb.hglu + row * d::CW + cc) = o; }
            }
        }
    }
}

constexpr int ATT_KP = 144, ATT_VP = 272;
constexpr int ATT_K_BYTES = 128 * ATT_KP, ATT_V_BYTES = 64 * ATT_VP;
__device__ __forceinline__ void att_unit(const OP& p, const PrepBufs& pb, LAS unsigned char* lds, int l, int kind, int b, int qblk, int kvh, int tid_, int lane_, int wave) {
    typedef Dims d;
    int tid = tid_; asm volatile("" : "+v"(tid)); const int lane = tid & 63;
    LAS unsigned char* Kt = lds; LAS unsigned char* Vt = lds + ATT_K_BYTES;
    const int g = wave >> 1, qh = wave & 1, h = kvh * d::G + g, q31 = lane & 31, hh = lane >> 5;
    const int rowq0 = (kind ? d::NL + b * d::C : b * d::S) + qblk * 128 + qh * 64;
    constexpr float SC = 0.125f * 1.4426950408889634f;
    bf16x8v qf[2][4];
#pragma unroll
    for (int qt = 0; qt < 2; ++qt)
#pragma unroll
        for (int ks = 0; ks < 4; ++ks) { const v4u w = *(const v4u*)(pb.qb + (size_t)(rowq0 + qt * 32 + q31) * d::AW + h * 64 + 16 * ks + 8 * hh); v4u o;
            o.x = cvtpk(BFLO(w.x) * SC, BFHI(w.x) * SC); o.y = cvtpk(BFLO(w.y) * SC, BFHI(w.y) * SC); o.z = cvtpk(BFLO(w.z) * SC, BFHI(w.z) * SC); o.w = cvtpk(BFLO(w.w) * SC, BFHI(w.w) * SC);
            qf[qt][ks] = __builtin_bit_cast(bf16x8v, o); }
    f32x16v O[2][2]; float m[2], lsum[2];
    const float sink2 = p.att_sink[(size_t)l * d::AH + h] * 1.4426950408889634f;
#pragma unroll
    for (int qt = 0; qt < 2; ++qt) { m[qt] = sink2; lsum[qt] = 1.0f;
#pragma unroll
        for (int dt = 0; dt < 2; ++dt)
#pragma unroll
            for (int i = 0; i < 16; ++i) O[qt][dt][i] = 0.f; }
    const int ngrp = kind ? 2 : 5;
#define AT_VALID(gi_) (!(kind == 0 && (gi_) < 3 && (qblk - 1 + (gi_) < 0 || qblk - 1 + (gi_) >= d::S / 128)))
#define AT_LOADG(gi_) do { int krow0_; const bf16* vsrc_; int voff_; \
        if (kind == 0 && (gi_) < 3) { const int kb_ = qblk - 1 + (gi_); krow0_ = b * d::S + kb_ * 128; vsrc_ = pb.vTl + ((size_t)(b * d::KVH + kvh) * 64) * d::S + kb_ * 128; voff_ = d::S; } \
        else { const int cg_ = kind ? (gi_) : (gi_) - 3; krow0_ = d::NL + b * d::C + cg_ * 128; vsrc_ = pb.vTc + ((size_t)(b * d::KVH + kvh) * 64) * d::C + cg_ * 128; voff_ = d::C; } \
        _Pragma("unroll") for (int i = 0; i < 2; ++i) { const int c = tid + MK_THREADS * i; \
            pk_[i] = *(const v4u*)(pb.kb + (size_t)(krow0_ + (c >> 3)) * d::KVW + kvh * 64 + (c & 7) * 8); pv_[i] = *(const v4u*)(vsrc_ + (size_t)(c >> 4) * voff_ + (c & 15) * 8); } } while (0)
    v4u pk_[2], pv_[2];
    int gnext = 0; while (gnext < ngrp && !AT_VALID(gnext)) ++gnext;
    if (gnext < ngrp) AT_LOADG(gnext);
    while (gnext < ngrp) {
        const int gi = gnext; const int mtype = (kind == 0 && gi == 0) ? 1 : ((kind == 0 && gi == 2) ? 2 : 0);
        __syncthreads();
#pragma unroll
        for (int i = 0; i < 2; ++i) { const int c = tid + MK_THREADS * i; *(LAS v4u*)(Kt + (c >> 3) * ATT_KP + (c & 7) * 16) = pk_[i]; *(LAS v4u*)(Vt + (c >> 4) * ATT_VP + (c & 15) * 16) = pv_[i]; }
        __syncthreads();
        ++gnext; while (gnext < ngrp && !AT_VALID(gnext)) ++gnext;
        if (gnext < ngrp) AT_LOADG(gnext);
        for (int kt = 0; kt < 4; ++kt) {
            bf16x8v kf[4];
#pragma unroll
            for (int ks = 0; ks < 4; ++ks) kf[ks] = *(const LAS bf16x8v*)(Kt + (kt * 32 + q31) * ATT_KP + (16 * ks + 8 * hh) * 2);
#pragma unroll
            for (int qt = 0; qt < 2; ++qt) {
                const int tq = 2 * qh + qt;
                if (mtype == 1 && kt < tq) continue;
                if (mtype == 2 && kt > tq) continue;
                f32x16v s;
#pragma unroll
                for (int i = 0; i < 16; ++i) s[i] = 0.f;
#pragma unroll
                for (int ks = 0; ks < 4; ++ks) s = MFMA32(kf[ks], qf[qt][ks], s);
                const int qq = tq * 32 + q31; float tmax = -3.0e38f;
#pragma unroll
                for (int i = 0; i < 16; ++i) tmax = fmaxf(tmax, s[i]);
                if (mtype != 0 && kt == tq) {
                    tmax = -3.0e38f;
#pragma unroll
                    for (int i = 0; i < 16; ++i) { const int kk = kt * 32 + crow32(i, hh); float x = s[i];
                        if (mtype == 1 ? kk < qq : kk > qq) x = -1.0e30f;
                        s[i] = x; tmax = fmaxf(tmax, x); } }
                tmax = xhalf_max(tmax);
                if (!__all(tmax <= m[qt])) {
                    const float mn = fmaxf(m[qt], tmax), corr = __builtin_amdgcn_exp2f(m[qt] - mn); m[qt] = mn; lsum[qt] *= corr;
#pragma unroll
                    for (int dt = 0; dt < 2; ++dt)
#pragma unroll
                        for (int i = 0; i < 16; ++i) O[qt][dt][i] *= corr; }
                const float mn = m[qt]; float ps = 0.f;
#pragma unroll
                for (int i = 0; i < 16; ++i) { s[i] = __builtin_amdgcn_exp2f(s[i] - mn); ps += s[i]; }
                ps = xhalf_sum(ps);
                lsum[qt] += ps;
#pragma unroll
                for (int st = 0; st < 2; ++st) {
                    v4u pk; pk.x = cvtpk(s[8 * st], s[8 * st + 1]); pk.y = cvtpk(s[8 * st + 2], s[8 * st + 3]); pk.z = cvtpk(s[8 * st + 4], s[8 * st + 5]); pk.w = cvtpk(s[8 * st + 6], s[8 * st + 7]);
                    const bf16x8v pf = __builtin_bit_cast(bf16x8v, pk);
#pragma unroll
                    for (int dt = 0; dt < 2; ++dt) {
                        const LAS unsigned char* vr = Vt + (32 * dt + q31) * ATT_VP + (kt * 32 + 16 * st + 4 * hh) * 2;
                        const u32x2v v0 = *(const LAS u32x2v*)vr, v1 = *(const LAS u32x2v*)(vr + 16);
                        v4u vv; vv.x = v0.x; vv.y = v0.y; vv.z = v1.x; vv.w = v1.y;
                        O[qt][dt] = MFMA32(__builtin_bit_cast(bf16x8v, vv), pf, O[qt][dt]);
                    }
                }
            }
        }
    }
#undef AT_VALID
#undef AT_LOADG
#pragma unroll
    for (int qt = 0; qt < 2; ++qt) { const float il = 1.0f / lsum[qt]; bf16* orow = p.mixbf + (size_t)(rowq0 + qt * 32 + q31) * d::D + h * 64;
#pragma unroll
        for (int dt = 0; dt < 2; ++dt)
#pragma unroll
            for (int rg = 0; rg < 4; ++rg) { u32x2v o; o.x = cvtpk(O[qt][dt][4 * rg] * il, O[qt][dt][4 * rg + 1] * il); o.y = cvtpk(O[qt][dt][4 * rg + 2] * il, O[qt][dt][4 * rg + 3] * il);
                *(u32x2v*)(orow + 32 * dt + 8 * rg + 4 * hh) = o; } }
}

__device__ __forceinline__ float ret_lg2(const OP& p, int l, int dir, int head) {
    const float z = p.ret_decay_logit[((size_t)l * 2 + dir) * Dims::RH + head]; return -log1pf(expf(-z)) * 1.4426950408889634f;
}
__device__ __forceinline__ bf16x8v scale_frag(const bf16x8v a, const float (&f)[8]) {
    const v4u w = __builtin_bit_cast(v4u, a); v4u o;
    o.x = cvtpk(__builtin_bit_cast(float, w.x << 16) * f[0], __builtin_bit_cast(float, w.x & 0xffff0000u) * f[1]);
    o.y = cvtpk(__builtin_bit_cast(float, w.y << 16) * f[2], __builtin_bit_cast(float, w.y & 0xffff0000u) * f[3]);
    o.z = cvtpk(__builtin_bit_cast(float, w.z << 16) * f[4], __builtin_bit_cast(float, w.z & 0xffff0000u) * f[5]);
    o.w = cvtpk(__builtin_bit_cast(float, w.w << 16) * f[6], __builtin_bit_cast(float, w.w & 0xffff0000u) * f[7]);
    return __builtin_bit_cast(bf16x8v, o);
}
__device__ __forceinline__ void ret_state_unit(const OP& p, const PrepBufs& pb, int l, int b, int head, int lane_, int wave) {
    typedef Dims d;
    int lane = lane_; asm volatile("" : "+v"(lane));
    const int dir = wave >> 2, dtile = (wave >> 1) & 1, etile = wave & 1, r31 = lane & 31, hh = lane >> 5;
    const float lg2 = ret_lg2(p, l, dir, head), cdec = exp2f(128.0f * lg2);
    f32x16v acc;
#pragma unroll
    for (int i = 0; i < 16; ++i) acc[i] = 0.f;
    const bf16* kTl = pb.rkTl + ((size_t)(b * d::RH + head) * 64 + 32 * dtile + r31) * d::S + 8 * hh; const bf16* kTc = pb.rkTc + ((size_t)(b * d::RH + head) * 64 + 32 * dtile + r31) * d::C + 8 * hh;
    const bf16* vTl = pb.rvTl + ((size_t)(b * d::RH + head) * 64 + 32 * etile + r31) * d::S + 8 * hh; const bf16* vTc = pb.rvTc + ((size_t)(b * d::RH + head) * 64 + 32 * etile + r31) * d::C + 8 * hh;
#define RS_GC(si) (dir == 0 ? (si) : ((si) < d::NCc ? d::NCc - 1 - (si) : d::NCc + (d::NCl - 1 - ((si) - d::NCc))))
#define RS_LOAD(A, B, gcv) do { const int _k = (gcv) < d::NCc ? 1 : 0, _pc = _k ? (gcv) : (gcv) - d::NCc; const bf16* _ka = (_k ? kTc : kTl) + _pc * 128; const bf16* _va = (_k ? vTc : vTl) + _pc * 128; \
        _Pragma("unroll") for (int ks = 0; ks < 8; ++ks) { A[ks] = *(const bf16x8v*)(_ka + 16 * ks); B[ks] = *(const bf16x8v*)(_va + 16 * ks); } } while (0)
    bf16x8v af[8], bfr[8], an[8], bn[8];
    RS_LOAD(af, bfr, RS_GC(0));
    for (int sidx = 0; sidx < d::NCH; ++sidx) {
        const int gc = RS_GC(sidx);
        if (sidx + 1 < d::NCH) RS_LOAD(an, bn, RS_GC(sidx + 1));
        bf16* sp = pb.sprevT + ((((size_t)(b * 2 + dir) * d::NCH + gc) * d::RH + head) * 64 + (32 * etile + r31)) * 64 + 32 * dtile;
#pragma unroll
        for (int rg = 0; rg < 4; ++rg) { u32x2v o; o.x = cvtpk(acc[4 * rg], acc[4 * rg + 1]); o.y = cvtpk(acc[4 * rg + 2], acc[4 * rg + 3]); *(u32x2v*)(sp + 8 * rg + 4 * hh) = o; }
#pragma unroll
        for (int i = 0; i < 16; ++i) acc[i] *= cdec;
        int hho = hh; asm volatile("" : "+v"(hho));
        const float e0 = lg2 * (float)(dir == 0 ? 127 - 8 * hho : 8 * hho), st1 = dir == 0 ? -lg2 : lg2;
#pragma unroll
        for (int ks = 0; ks < 8; ++ks) { float f[8];
#pragma unroll
            for (int jj = 0; jj < 8; ++jj) f[jj] = __builtin_amdgcn_exp2f(e0 + st1 * (float)(16 * ks + jj));
            acc = MFMA32(scale_frag(af[ks], f), bfr[ks], acc); }
#pragma unroll
        for (int ks = 0; ks < 8; ++ks) { af[ks] = an[ks]; bfr[ks] = bn[ks]; }
    }
#undef RS_GC
#undef RS_LOAD
}
constexpr int RO_KP = 144, RO_VP = 272, RO_K = 0, RO_V = 128 * RO_KP, RO_SF = RO_V + 64 * RO_VP, RO_SB = RO_SF + 64 * RO_KP, RO_SUB = RO_SB + 64 * RO_KP;
__device__ __forceinline__ void phase_retout(const OP& p, const PrepBufs& pb, LAS unsigned char* lds, int G, int l, bool last) {
    typedef Dims d;
    int t_ = threadIdx.x; asm volatile("" : "+v"(t_)); const int tid = t_, lane = tid & 63, wave = __builtin_amdgcn_readfirstlane(tid >> 6);
    const int sub = wave >> 2, qt = wave & 3;
    LAS unsigned char* base = lds + sub * RO_SUB;
    const int nch = last ? d::NCl : d::NCH, NU2 = d::B * nch * d::RH / 2;
    for (int u2 = blockIdx.x; u2 < NU2; u2 += G) {
        int tq_ = tid; asm volatile("" : "+v"(tq_)); const int t4 = tq_ & 255, r31 = tq_ & 31, hh = (tq_ >> 5) & 1;
        const int u = 2 * u2 + sub, head = u % d::RH, cidx = (u / d::RH) % nch, b = u / (d::RH * nch), gc = last ? cidx + d::NCc : cidx;
        const int kind = gc < d::NCc ? 1 : 0, pc = kind ? gc : gc - d::NCc, L = kind ? d::C : d::S, row0 = (kind ? d::NL + b * d::C : b * d::S) + pc * 128;
        __syncthreads();
#pragma unroll
        for (int i = 0; i < 4; ++i) { const int c = t4 + 256 * i;
            { const int key = c >> 3, part = c & 7; *(LAS v4u*)(base + RO_K + key * RO_KP + part * 16) = *(const v4u*)(pb.rkb + (size_t)(row0 + key) * d::RW + head * 64 + part * 8); }
            { const int e = c >> 4, part = c & 15; const bf16* vT = (kind ? pb.rvTc + ((size_t)(b * d::RH + head) * 64) * d::C : pb.rvTl + ((size_t)(b * d::RH + head) * 64) * d::S);
              *(LAS v4u*)(base + RO_V + e * RO_VP + part * 16) = *(const v4u*)(vT + (size_t)e * L + pc * 128 + part * 8); } }
#pragma unroll
        for (int i = 0; i < 2; ++i) { const int c = t4 + 256 * i, e = c >> 3, part = c & 7;
            *(LAS v4u*)(base + RO_SF + e * RO_KP + part * 16) = *(const v4u*)(pb.sprevT + ((((size_t)(b * 2 + 0) * d::NCH + gc) * d::RH + head) * 64 + e) * 64 + part * 8);
            *(LAS v4u*)(base + RO_SB + e * RO_KP + part * 16) = *(const v4u*)(pb.sprevT + ((((size_t)(b * 2 + 1) * d::NCH + gc) * d::RH + head) * 64 + e) * 64 + part * 8); }
        const int irow = qt * 32 + r31, row = row0 + irow;
        bf16x8v qf[4];
#pragma unroll
        for (int ks = 0; ks < 4; ++ks) qf[ks] = *(const bf16x8v*)(pb.rqb + (size_t)row * d::RW + head * 64 + 16 * ks + 8 * hh);
        u32x2v gpre[2][4];
        { const bf16* gate_ = (const bf16*)p.u + (size_t)row * d::INC + d::oRG + head * 64;
#pragma unroll
          for (int dt = 0; dt < 2; ++dt)
#pragma unroll
              for (int rg = 0; rg < 4; ++rg) gpre[dt][rg] = *(const u32x2v*)(gate_ + 32 * dt + 8 * rg + 4 * hh); }
        const float lgf = ret_lg2(p, l, 0, head), lgb = ret_lg2(p, l, 1, head);
        float cf16[16], cb16[16];
#pragma unroll
        for (int i = 0; i < 16; ++i) { const float cr = (float)((i & 3) + 8 * (i >> 2)); cf16[i] = __builtin_amdgcn_exp2f(-lgf * cr); cb16[i] = __builtin_amdgcn_exp2f(lgb * cr); }
        __syncthreads();
        f32x16v o[2];
        {
            const float cf = exp2f(lgf * (float)(irow + 1)), cb = exp2f(lgb * (float)(128 - irow));
#pragma unroll
            for (int dt = 0; dt < 2; ++dt) { f32x16v af, ab;
#pragma unroll
                for (int i = 0; i < 16; ++i) { af[i] = 0.f; ab[i] = 0.f; }
#pragma unroll
                for (int ks = 0; ks < 4; ++ks) {
                    af = MFMA32(*(const LAS bf16x8v*)(base + RO_SF + (32 * dt + r31) * RO_KP + (16 * ks + 8 * hh) * 2), qf[ks], af);
                    ab = MFMA32(*(const LAS bf16x8v*)(base + RO_SB + (32 * dt + r31) * RO_KP + (16 * ks + 8 * hh) * 2), qf[ks], ab); }
#pragma unroll
                for (int i = 0; i < 16; ++i) o[dt][i] = af[i] * cf + ab[i] * cb; }
        }
        for (int kt = 0; kt < 4; ++kt) {
            f32x16v s;
#pragma unroll
            for (int i = 0; i < 16; ++i) s[i] = 0.f;
#pragma unroll
            for (int ks = 0; ks < 4; ++ks) s = MFMA32(*(const LAS bf16x8v*)(base + RO_K + (kt * 32 + r31) * RO_KP + (16 * ks + 8 * hh) * 2), qf[ks], s);
            const int dbase = irow - (kt * 32 + 4 * hh);
            if (kt < qt) { const float tf = __builtin_amdgcn_exp2f(lgf * (float)dbase);
#pragma unroll
                for (int i = 0; i < 16; ++i) s[i] *= tf * cf16[i]; }
            else if (kt > qt) { const float tb = __builtin_amdgcn_exp2f(lgb * (float)(-dbase));
#pragma unroll
                for (int i = 0; i < 16; ++i) s[i] *= tb * cb16[i]; }
            else { const float tf = __builtin_amdgcn_exp2f(lgf * (float)dbase), tb = __builtin_amdgcn_exp2f(lgb * (float)(-dbase));
#pragma unroll
                for (int i = 0; i < 16; ++i) { const int cr = (i & 3) + 8 * (i >> 2); s[i] *= (cr <= dbase) ? tf * cf16[i] : tb * cb16[i]; } }
#pragma unroll
            for (int st = 0; st < 2; ++st) {
                v4u pk; pk.x = cvtpk(s[8 * st], s[8 * st + 1]); pk.y = cvtpk(s[8 * st + 2], s[8 * st + 3]); pk.z = cvtpk(s[8 * st + 4], s[8 * st + 5]); pk.w = cvtpk(s[8 * st + 6], s[8 * st + 7]);
                const bf16x8v pf = __builtin_bit_cast(bf16x8v, pk);
#pragma unroll
                for (int dt = 0; dt < 2; ++dt) {
                    const LAS unsigned char* vr = base + RO_V + (32 * dt + r31) * RO_VP + (kt * 32 + 16 * st + 4 * hh) * 2;
                    const u32x2v v0 = *(const LAS u32x2v*)vr, v1 = *(const LAS u32x2v*)(vr + 16);
                    v4u vv; vv.x = v0.x; vv.y = v0.y; vv.z = v1.x; vv.w = v1.y;
                    o[dt] = MFMA32(__builtin_bit_cast(bf16x8v, vv), pf, o[dt]);
                }
            }
        }
        float sm = 0.f;
#pragma unroll
        for (int dt = 0; dt < 2; ++dt)
#pragma unroll
            for (int i = 0; i < 16; ++i) sm += o[dt][i];
        sm = xhalf_sum(sm); const float mu = sm * (1.0f / 64.0f); float vr2 = 0.f;
#pragma unroll
        for (int dt = 0; dt < 2; ++dt)
#pragma unroll
            for (int i = 0; i < 16; ++i) { const float t = o[dt][i] - mu; vr2 += t * t; }
        vr2 = xhalf_sum(vr2); const float rs = 1.0f / sqrtf(vr2 * (1.0f / 64.0f) + 1e-6f);
        const float* gn = p.ret_norm_g + (size_t)l * d::RW + head * 64; bf16* orow = p.mixbf + (size_t)row * d::D + d::AW + head * 64;
#pragma unroll
        for (int dt = 0; dt < 2; ++dt)
#pragma unroll
            for (int rg = 0; rg < 4; ++rg) { const int e0 = 32 * dt + 8 * rg + 4 * hh; const f32x4v g4 = *(const f32x4v*)(gn + e0); const u32x2v tw = gpre[dt][rg]; const f32x4v t4v = (f32x4v){BFLO(tw.x), BFHI(tw.x), BFLO(tw.y), BFHI(tw.y)};
                const float y0 = (o[dt][4 * rg] - mu) * rs * g4.x * fast_silu(t4v.x), y1 = (o[dt][4 * rg + 1] - mu) * rs * g4.y * fast_silu(t4v.y);
                const float y2 = (o[dt][4 * rg + 2] - mu) * rs * g4.z * fast_silu(t4v.z), y3 = (o[dt][4 * rg + 3] - mu) * rs * g4.w * fast_silu(t4v.w);
                u32x2v ov; ov.x = cvtpk(y0, y1); ov.y = cvtpk(y2, y3); *(u32x2v*)(orow + e0) = ov; }
    }
    __syncthreads();
}
constexpr int CV_HG = 0, CV_W = 94 * 512, CV_P = CV_W + 31 * 1024;
__device__ __forceinline__ void conv_unit(const OP& p, const PrepBufs& pb, LAS unsigned char* lds, int l, int u, int tid_, int lane_, int wave) {
    typedef Dims d;
    int tid = tid_; asm volatile("" : "+v"(tid)); const int lane = tid & 63;
    const int r0 = u * 64; const int kind = r0 >= d::NL ? 1 : 0; const int t0 = kind ? (r0 - d::NL) % d::C : r0 % d::S, L = kind ? d::C : d::S;
    __syncthreads();
    {
        v4u hv[6]; f32x4v wv[4];
#pragma unroll
        for (int i = 0; i < 6; ++i) { const int c = tid + MK_THREADS * i, lr = c >> 5, part = c & 31, t = t0 - 15 + lr; const bool ok = (c < 94 * 32) && t >= 0 && t < L;
            hv[i] = *(const v4u*)(pb.hglu + (size_t)(ok ? r0 - 15 + lr : r0) * d::CW + part * 8); if (!ok) hv[i] = (v4u){0u, 0u, 0u, 0u}; }
#pragma unroll
        for (int i = 0; i < 4; ++i) { const int c = tid + MK_THREADS * i; wv[i] = *(const f32x4v*)(p.conv_w + (size_t)l * 31 * d::CW + (c < 31 * 64 ? c : 0) * 4); }
#pragma unroll
        for (int i = 0; i < 6; ++i) { const int c = tid + MK_THREADS * i; if (c < 94 * 32) *(LAS v4u*)(lds + CV_HG + (c >> 5) * 512 + (c & 31) * 16) = hv[i]; }
#pragma unroll
        for (int i = 0; i < 4; ++i) { const int c = tid + MK_THREADS * i; if (c < 31 * 64) *(LAS f32x4v*)(lds + CV_W + c * 16) = wv[i]; }
    }
    if (tid < 192) { const int which = tid >> 6, cc = tid & 63; const float* src = which == 0 ? p.conv_b : (which == 1 ? p.conv_norm_g : p.conv_norm_b);
        *(LAS f32x4v*)(lds + CV_P + which * 1024 + cc * 16) = *(const f32x4v*)(src + (size_t)l * d::CW + cc * 4); }
    __syncthreads();
    const int lr0 = 8 * wave;
    f32x4v acc[8];
    { const f32x4v bias = *(const LAS f32x4v*)(lds + CV_P + lane * 16);
#pragma unroll
      for (int i = 0; i < 8; ++i) acc[i] = bias; }
#pragma unroll
    for (int jh = 0; jh < 4; ++jh) {
        constexpr int JN = 8; const int j0 = jh * JN;
        int lw = lane; asm volatile("" : "+v"(lw));
        f32x4v w[JN];
#pragma unroll
        for (int j = 0; j < JN; ++j) w[j] = *(const LAS f32x4v*)(lds + CV_W + (j0 + j < 31 ? j0 + j : 30) * 1024 + lw * 16);
#pragma unroll
        for (int t = 0; t < 38; ++t) {
            if (t - 7 >= j0 + JN || t < j0) continue;
            const u32x2v hv = *(const LAS u32x2v*)(lds + CV_HG + (lr0 + t) * 512 + lw * 8);
            const f32x4v h4 = (f32x4v){BFLO(hv.x), BFHI(hv.x), BFLO(hv.y), BFHI(hv.y)};
#pragma unroll
            for (int i = 0; i < 8; ++i) { const int j = t - i; if (j >= j0 && j < j0 + JN && j < 31) acc[i] += h4 * w[j - j0]; }
            asm volatile("" ::: "memory");
        }
    }
    const f32x4v g4 = *(const LAS f32x4v*)(lds + CV_P + 1024 + lane * 16), b4 = *(const LAS f32x4v*)(lds + CV_P + 2048 + lane * 16);
#pragma unroll
    for (int i = 0; i < 8; ++i) {
        const float mu = wave_sum((acc[i].x + acc[i].y) + (acc[i].z + acc[i].w)) * (1.0f / d::CW); const f32x4v dv = acc[i] - mu;
        const float rs = 1.0f / sqrtf(wave_sum((dv.x * dv.x + dv.y * dv.y) + (dv.z * dv.z + dv.w * dv.w)) * (1.0f / d::CW) + 1e-6f);
        const f32x4v y = dv * rs * g4 + b4;
        u32x2v ov; ov.x = cvtpk(fast_silu(y.x), fast_silu(y.y)); ov.y = cvtpk(fast_silu(y.z), fast_silu(y.w));
        *(u32x2v*)(p.mixbf + (size_t)(r0 + lr0 + i) * d::D + d::AW + d::RW + 4 * lane) = ov;
    }
}
template <int MASK = 7> __device__ __forceinline__ void phase_mix(const OP& p, const PrepBufs& pb, LAS unsigned char* lds, unsigned* qctr, int l, bool last) {
    typedef Dims d;
    int t_ = threadIdx.x; asm volatile("" : "+v"(t_)); const int tid = t_, lane = tid & 63, wave = __builtin_amdgcn_readfirstlane(tid >> 6);
    constexpr int NS = d::B * d::RH, NUL = d::B * (d::S / 128) * d::KVH, NUC = d::B * (d::C / 128) * d::KVH;
    const int NA = NUL + (last ? 0 : NUC), NCV = (last ? d::NL : d::NR) / 64, NT = NS + NA + NCV;
    LAS int* qslot = (LAS int*)(lds + MISC_OFF + 64);
    for (;;) {
        __syncthreads();
        if (tid == 0) qslot[0] = (int)__hip_atomic_fetch_add(qctr, 1u, __ATOMIC_RELAXED, __HIP_MEMORY_SCOPE_AGENT);
        __syncthreads();
        const int v = qslot[0];
        if (v >= NT) break;
        if (v < NS) { if (MASK & 1) ret_state_unit(p, pb, l, v / d::RH, v % d::RH, lane, wave); }
        else if (v < NS + NA) { const int u = v - NS; int kind, b, qblk, kvh;
            if (u < NUL) { kind = 0; kvh = u % d::KVH; qblk = (u / d::KVH) % (d::S / 128); b = u / (d::KVH * (d::S / 128)); }
            else { const int w = u - NUL; kind = 1; kvh = w % d::KVH; qblk = (w / d::KVH) % (d::C / 128); b = w / (d::KVH * (d::C / 128)); }
            if (MASK & 2) att_unit(p, pb, lds, l, kind, b, qblk, kvh, tid, lane, wave); }
        else { if (MASK & 4) conv_unit(p, pb, lds, l, v - NS - NA, tid, lane, wave); }
    }
    __syncthreads();
}

__global__ void __launch_bounds__(MK_THREADS, 2) mk_fwd(const OP p, const PrepBufs pb, unsigned* ctl) {
    extern __shared__ __attribute__((aligned(16))) unsigned char lds[];
    if (threadIdx.x < 64) ((LAS unsigned*)(lds + MISC_OFF))[threadIdx.x] = 0u;
    __syncthreads();
    (void)xcd_barrier_post(ctl + CW_BAR, (volatile LAS unsigned*)(lds + MISC_OFF));
#define GRID_BAR() do { XcdBarrier b_; b_.bar = ctl + CW_BAR; b_.x = xb_xcc_id(); b_.st = (volatile LAS unsigned*)(lds + MISC_OFF); xcd_barrier(b_); } while (0)
    const int G = gridDim.x, ngw = G * 8;
    LAS unsigned char* ldsp = (LAS unsigned char*)lds;
#define MK_CONV(...) do { int _t = threadIdx.x; asm volatile("" : "+v"(_t)); const int lane = _t & 63, wave = __builtin_amdgcn_readfirstlane(_t >> 6); const int gw = blockIdx.x * 8 + wave; LAS float* scr = (LAS float*)(ldsp + wave * 16384); conv_group(__VA_ARGS__, scr, gw, ngw, lane); } while (0)
    const Dims& d = p.d;
    MK_CONV(p.w_in, (size_t)d.D * d.INC, d.DEPTH, d.D, d.INC, p.wInT, (size_t)d.INC * d.D, 0);
    MK_CONV(p.w_out, (size_t)d.D * d.D, d.DEPTH, d.D, d.D, p.wOutT, (size_t)d.D * d.D, 0);
    __syncthreads();
    phase_mod(p, ldsp, G); GRID_BAR();
    phase_rows<8>(p, ldsp, G, p.x, p.ctx, d.NR, 0, 0, 0); GRID_BAR();
#pragma unroll
    for (int l = 0; l < d.DEPTH; ++l) {
        const bool last = (l == d.DEPTH - 1);
        {
            pg8::Gemm g{p.hbf, p.wInT + (size_t)l * d.INC * d.D, d.D}; pg8::WinOrder S;
            if (last) S.init(d.NL / 256, (d.NR - d.NL) / 256, d.INC / 256, 3, 0x542, G, (int)blockIdx.x); else S.init(d.NR / 256, 0, d.INC / 256, 0, 0, G, (int)blockIdx.x);
            pg8::EpiBf16 E{(bf16*)p.u, d.INC};
            pg8::gemm_phase(ldsp, g, S, E);
        }
        if (l == 0) conv_ffn_dyn(p, l, ctl + CW_QUEUE + 64 * l + 32, ldsp, 0, 2 * d.E * 176); else conv_ffn_dyn(p, l, ctl + CW_QUEUE + 64 * l + 33, ldsp, 2 * d.E * 176, d.E * 176);
        GRID_BAR();
        phase_prep<7>(p, pb, ldsp, G, l, last); GRID_BAR();
        phase_mix(p, pb, ldsp, ctl + CW_QUEUE + 64 * l, l, last); GRID_BAR();
        phase_retout(p, pb, ldsp, G, l, last);
        if (l == 0) conv_ffn_dyn(p, l, ctl + CW_QUEUE + 64 * l + 35, ldsp, 2 * d.E * 176, d.E * 88);
        GRID_BAR();
        const int mrows = last ? d.NL : d.NR;
        {
            pg8::Gemm g{p.mixbf, p.wOutT + (size_t)l * d.D * d.D, d.D}; pg8::DenseOrder S; S.init(mrows / 256, d.D / 256, G, (int)blockIdx.x);
            pg8::EpiResid E{p.xcur, l == 0 ? p.x : p.xcur, l == 0 ? p.ctx : p.xcur + (size_t)d.NL * d.D, d.D, p.mod + (size_t)l * (d.B + 1) * 6 * d.D, 2 * d.D, d.NL, d.S, d.B};
            pg8::gemm_phase(ldsp, g, S, E);
            if (l == 0) conv_ffn_dyn(p, l, ctl + CW_QUEUE + 64 * l + 33, ldsp, 2 * d.E * 176 + d.E * 88, d.E * 88);
            GRID_BAR();
        }
        phase_router(p, ldsp, G, p.xcur, p.xcur + (size_t)d.NL * d.D, mrows, l); GRID_BAR();
        phase_topk(p, ldsp, G, !last); GRID_BAR();
        {
            pg8::Gemm g{p.hbf, p.ffnW1, d.D / 2, p.rowidx, TBL_OFF}; pg8::ExpertOrder S; S.init(2 * d.FF / 256, d.NSL / d.E / 256, last ? 0 : d.NSC / d.E / 256, d.E, G, (int)blockIdx.x);
            pg8::EpiSwiGLU8T E{(unsigned char*)p.hmidb, d.FF / 128, -LOG2E / W1_SCALE, W1_SCALE * W1_SCALE / H_SCALE};
            pg8::gemm_phase<pg8::EpiSwiGLU8T, pg8::ExpertOrder, true, true, true, false, true, true>(ldsp, g, S, E); GRID_BAR();
        }
        {
            pg8::Gemm g{p.hmidb, p.ffnW2, d.FF / 2}; pg8::ExpertOrder S; S.init(d.D / 256, d.NSL / d.E / 256, last ? 0 : d.NSC / d.E / 256, d.E, G, (int)blockIdx.x);
            pg8::EpiDown E{p.ybufb, d.D, p.gate, 1.0f / (W2_SCALE * H_SCALE)};
            pg8::gemm_phase<pg8::EpiDown, pg8::ExpertOrder, true, true, true, true, true>(ldsp, g, S, E);
            if (!last) conv_ffn_dyn(p, l + 1, ctl + CW_QUEUE + 64 * l + 34, ldsp, 0, 2 * d.E * 176);
            GRID_BAR();
        }
        if (!last) { phase_rows<1 | 2 | 8>(p, ldsp, G, p.xcur, p.xcur + (size_t)d.NL * d.D, d.NR, l, l + 1, 0); GRID_BAR(); }
        else { phase_rows<1 | 4>(p, ldsp, G, p.xcur, p.xcur + (size_t)d.NL * d.D, d.NL, l, l, 0); }
    }
}

static inline void fill_inputs(OP& p, void* const* d_in) {
    p.x = (const float*)d_in[0]; p.c = (const float*)d_in[1]; p.ctx = (const float*)d_in[2]; p.c_ctx = (const float*)d_in[3]; p.w_mod = (const float*)d_in[4]; p.b_mod = (const float*)d_in[5];
    p.g_mix = (const float*)d_in[6]; p.g_ffn = (const float*)d_in[7]; p.w_in = (const float*)d_in[8]; p.q_norm_g = (const float*)d_in[9]; p.k_norm_g = (const float*)d_in[10]; p.att_sink = (const float*)d_in[11];
    p.ret_decay_logit = (const float*)d_in[12]; p.ret_norm_g = (const float*)d_in[13]; p.conv_w = (const float*)d_in[14]; p.conv_b = (const float*)d_in[15]; p.conv_norm_g = (const float*)d_in[16];
    p.conv_norm_b = (const float*)d_in[17]; p.w_out = (const float*)d_in[18]; p.w_router = (const float*)d_in[19]; p.w_gate = (const float*)d_in[20]; p.w_up = (const float*)d_in[21]; p.w_down = (const float*)d_in[22];
}
static inline size_t carve_ws(OP& p, PrepBufs& pb, unsigned char* ws) {
    const Dims& d = p.d; size_t off = WS_CTL_BYTES;
    auto take = [&](size_t bytes) { void* q = ws + off; off += (bytes + 255) & ~(size_t)255; return q; };
    const size_t NR = d.NR, D = d.D;
    p.wInT = (bf16*)take((size_t)d.DEPTH * d.INC * D * 2); p.wOutT = (bf16*)take((size_t)d.DEPTH * D * D * 2);
    p.ffnW1 = (bf16*)take((size_t)d.E * 2 * d.FF * D * 2); p.ffnW2 = (bf16*)take((size_t)d.E * D * d.FF * 2);
    p.mod = (float*)take((size_t)d.DEPTH * (d.B + 1) * 6 * D * 4);
    p.xcur = (float*)take(NR * D * 4);
    p.hbf = (bf16*)take(NR * D * 2); p.mixbf = (bf16*)take(NR * D * 2);
    p.aff = (float*)take(NR * d.E * 4);
    p.rowidx = (int*)take((size_t)(d.NSL + d.NSC) * 4); p.gate = (float*)take((size_t)(d.NSL + d.NSC) * 4); p.slotof = (int*)take(NR * d.E * 4);
    { const size_t a0 = off; p.u = (float*)take(NR * d.INC * 4); p.hmidb = (bf16*)(ws + a0);
      const size_t need = (size_t)(d.NSL + d.NSC) * d.FF * 2; if (off - a0 < need) off = a0 + ((need + 255) & ~(size_t)255); }
    { const size_t b0 = off; pb.qb = (bf16*)take(NR * d.AW * 2); pb.kb = (bf16*)take(NR * d.KVW * 2);
      pb.vTl = (bf16*)take((size_t)d.B * d.KVH * 64 * d.S * 2); pb.vTc = (bf16*)take((size_t)d.B * d.KVH * 64 * d.C * 2);
      pb.rqb = (bf16*)take(NR * d.RW * 2); pb.rkb = (bf16*)take(NR * d.RW * 2);
      pb.rkTl = (bf16*)take((size_t)d.B * d.RH * 64 * d.S * 2); pb.rkTc = (bf16*)take((size_t)d.B * d.RH * 64 * d.C * 2);
      pb.rvTl = (bf16*)take((size_t)d.B * d.RH * 64 * d.S * 2); pb.rvTc = (bf16*)take((size_t)d.B * d.RH * 64 * d.C * 2);
      pb.hglu = (bf16*)take(NR * d.CW * 2); pb.sprevT = (bf16*)take((size_t)d.B * 2 * d.NCH * d.RH * 4096 * 2);
      const size_t xb = (size_t)(d.NSL + d.NSC) * D * 2; p.xe = (bf16*)(ws + b0); p.ybufb = (bf16*)(ws + b0 + ((xb + 255) & ~(size_t)255));
      const size_t need = 2 * ((xb + 255) & ~(size_t)255); if (off - b0 < need) off = b0 + need; }
    return off;
}
extern "C" void kernel_launch(void* const* d_in, const int* in_sizes, int n_in, void* d_out, int out_size, void* d_ws, size_t ws_size, hipStream_t stream) {
    (void)in_sizes; (void)n_in; (void)out_size;
    static int grid = 0;
    if (grid == 0) {
        int dev = 0, cus = 0, per_cu = 0;
        if (hipGetDevice(&dev) != hipSuccess || hipDeviceGetAttribute(&cus, hipDeviceAttributeMultiprocessorCount, dev) != hipSuccess) { fprintf(stderr, "kernel_launch: device query failed\n"); grid = -1; return; }
        if (hipFuncSetAttribute((const void*)mk_fwd, hipFuncAttributeMaxDynamicSharedMemorySize, LDS_BYTES) != hipSuccess) { fprintf(stderr, "kernel_launch: hipFuncSetAttribute failed\n"); grid = -1; return; }
        if (hipOccupancyMaxActiveBlocksPerMultiprocessor(&per_cu, (const void*)mk_fwd, MK_THREADS, LDS_BYTES) != hipSuccess || per_cu < 1) { fprintf(stderr, "kernel_launch: occupancy query says %d blocks per CU\n", per_cu); }
        (void)hipGetLastError();
        grid = cus;
    }
    if (grid < 0) return;
    OP p; memset(&p, 0, sizeof(p)); const Dims& d = p.d;
    {
        const int per = (2 * d.FF / 256) * ((d.NSL + d.NSC) / d.E / 256), tot = d.E * per;
        const int per_wg = (grid % 8 == 0 && d.E % 8 == 0) ? ((d.E / 8) * per + grid / 8 - 1) / (grid / 8) : (tot + grid - 1) / grid;
        if (per_wg > TBL_UNITS) { fprintf(stderr, "kernel_launch: %d expert-GEMM units per workgroup exceed the LDS row-index table (%d)\n", per_wg, TBL_UNITS); return; }
    }
    fill_inputs(p, d_in);
    PrepBufs pb; memset(&pb, 0, sizeof(pb));
    const size_t used = carve_ws(p, pb, (unsigned char*)d_ws);
    if (used > ws_size) { fprintf(stderr, "kernel_launch: workspace too small (%zu > %zu)\n", used, ws_size); return; }
    p.out = (float*)d_out;
    if (hipMemsetAsync(d_ws, 0, WS_CTL_BYTES, stream) != hipSuccess) { fprintf(stderr, "kernel_launch: memset failed\n"); return; }
    unsigned* ctl = (unsigned*)d_ws;
    hipLaunchKernelGGL(mk_fwd, dim3(grid), dim3(MK_THREADS), LDS_BYTES, stream, p, pb, ctl);
    const hipError_t le = hipPeekAtLastError();
    if (le != hipSuccess) fprintf(stderr, "kernel_launch: launch failed: %s\n", hipGetErrorName(le));
}
```

```cpp
#include <hip/hip_runtime.h>
#include <cstdio>
#include <cmath>
#include <cstdint>
#define HD_ __host__ __device__ __forceinline__
struct Dims {
    static constexpr int B = 16, S = 2048, C = 256, D = 1024, DEPTH = 2, GRID_W = 64, AH = 8, KVH = 2, RH = 4, E = 16, FF = 2816;
    static constexpr int AW = AH * 64, KVW = KVH * 64, RW = RH * 64, CW = D - AW - RW, INC = AW + 2 * KVW + 4 * RW + 2 * CW;
    static constexpr int NL = B * S, NR = B * (S + C), NCc = C / 128, NCl = S / 128, NCH = NCc + NCl;
    static constexpr int capL = 2 * S / E, capC = 2 * C / E, NSL = B * E * capL, NSC = B * E * capC, G = AH / KVH;
    static constexpr int oAQ = 0, oAK = AW, oAV = AW + KVW, oRQ = AW + 2 * KVW, oRK = oRQ + RW, oRV = oRK + RW, oRG = oRV + RW, oCV = oRG + RW;
    int pad_;
};

struct OP {
    Dims d;
    const float *x, *c, *ctx, *c_ctx, *w_mod, *b_mod, *g_mix, *g_ffn, *w_in, *q_norm_g, *k_norm_g, *att_sink, *ret_decay_logit,
        *ret_norm_g, *conv_w, *conv_b, *conv_norm_g, *conv_norm_b, *w_out, *w_router, *w_gate, *w_up, *w_down;
    float *mod;
    float *xcur;
    float *u;
    float *aff;
    int *rowidx;
    float *gate;
    int *slotof;
    float *out;
    unsigned short *hbf, *mixbf, *xe, *hmidb, *ybufb, *wInT, *wOutT, *ffnW1, *ffnW2;
};

#define XB_TMO      128
#define XB_XCNT(j)  (256  + 64 * (j))
#define XB_XSUB(j)  (1280 + 64 * (j))
#define XB_XGEN(j)  (2304 + 64 * (j))
#define XB_TOP      3328
#define XB_TOPGEN   3392
#define XCD_BAR_WORDS 3456
#define XB_SPIN_CAP (1u << 18)
#define LAS __attribute__((address_space(3)))

__device__ __forceinline__ unsigned xb_ld(unsigned* p)              { return __hip_atomic_load(p, __ATOMIC_RELAXED, __HIP_MEMORY_SCOPE_AGENT); }
__device__ __forceinline__ unsigned xb_add(unsigned* p, unsigned v) { return __hip_atomic_fetch_add(p, v, __ATOMIC_RELAXED, __HIP_MEMORY_SCOPE_AGENT); }
__device__ __forceinline__ unsigned xb_xcc_id() { return (unsigned)__builtin_amdgcn_s_getreg((3 << 11) | 20) & 0xFu; }
#define XB_SPIN(cond, bar) do { unsigned _sp = 0; while (cond) { __builtin_amdgcn_s_sleep(1); \
    if ((++_sp & 255u) == 0u) { if (xb_ld(&(bar)[XB_TMO])) break; if (_sp > XB_SPIN_CAP) { atomicAdd(&(bar)[XB_TMO], 1u); break; } } } } while (0)

struct XcdBarrier {
    unsigned* bar; unsigned x;
    volatile LAS unsigned* st;
};

__device__ __forceinline__ XcdBarrier xcd_barrier_post(unsigned* bar, volatile LAS unsigned* st) {
    XcdBarrier b; b.bar = bar; b.x = xb_xcc_id(); b.st = st;
    if (threadIdx.x == 0) (void)xb_add(&bar[XB_XCNT(b.x)], 1u);
    return b;
}
__device__ __forceinline__ void xcd_barrier_complete(unsigned* bar, unsigned x, unsigned& nloc, unsigned& nx) {
    const unsigned G = gridDim.x * gridDim.y * gridDim.z;
    unsigned sum, cnt, mine, sp = 0u;
    for (;;) {
        sum = 0u; cnt = 0u; mine = 0u;
#pragma unroll
        for (unsigned j = 0; j < 16; ++j) { const unsigned c = xb_ld(&bar[XB_XCNT(j)]); sum += c; cnt += (c > 0u) ? 1u : 0u; mine = (j == x) ? c : mine; }
        if (sum == G) break;
        __builtin_amdgcn_s_sleep(1);
        if ((++sp & 255u) == 0u) { if (xb_ld(&bar[XB_TMO])) break; if (sp > XB_SPIN_CAP) { atomicAdd(&bar[XB_TMO], 1u); break; } }
    }
    nloc = mine > 0u ? mine : 1u; nx = cnt > 0u ? cnt : 1u;
}

__device__ __forceinline__ void xcd_barrier(const XcdBarrier& b) {
    asm volatile("s_waitcnt vmcnt(0)" ::: "memory");
    __syncthreads();
    if (threadIdx.x == 0) {
        unsigned* bar = b.bar;
        __builtin_amdgcn_s_waitcnt(0);
        unsigned nloc = b.st[0], nx = b.st[1];
        if (nloc == 0u) { xcd_barrier_complete(bar, b.x, nloc, nx); b.st[0] = nloc; b.st[1] = nx; }
        const unsigned old = xb_add(&bar[XB_XSUB(b.x)], 1u);
        const unsigned gen = old / nloc;
        if (old + 1u == (gen + 1u) * nloc) {
            __builtin_amdgcn_fence(__ATOMIC_RELEASE, "agent");
            asm volatile("s_waitcnt vmcnt(0)" ::: "memory");
            const unsigned og = xb_add(&bar[XB_TOP], 1u);
            const unsigned tg = og / nx;
            if (og + 1u == (tg + 1u) * nx) xb_add(&bar[XB_TOPGEN], 1u);
            else XB_SPIN(xb_ld(&bar[XB_TOPGEN]) == tg, bar);
            __builtin_amdgcn_fence(__ATOMIC_ACQUIRE, "agent");
            xb_add(&bar[XB_XGEN(b.x)], 1u);
            asm volatile("s_waitcnt vmcnt(0)" ::: "memory");
        } else {
            XB_SPIN(xb_ld(&bar[XB_XGEN(b.x)]) == gen, bar);
            __builtin_amdgcn_fence(__ATOMIC_ACQUIRE, "agent");
            asm volatile("s_waitcnt vmcnt(0)" ::: "memory");
        }
    }
    __syncthreads();
}
namespace pg8 {
#define PG8_LAS __attribute__((address_space(3)))
typedef unsigned short bf16_t;
typedef short bf16x8 __attribute__((ext_vector_type(8)));
typedef float f32x4 __attribute__((ext_vector_type(4)));
typedef float f32x2 __attribute__((ext_vector_type(2)));
typedef unsigned u32x4 __attribute__((ext_vector_type(4)));
typedef unsigned u32x2 __attribute__((ext_vector_type(2)));
constexpr int BM = 256, BK = 64, HALF = 128, HTB = HALF * BK * 2  , STAGE_BYTES = 8 * HTB, NXCD = 8, WGM = 8;

__host__ __device__ __forceinline__ int lds_byte(int r, int c) { const int st = (r >> 4) * 2 + (c >> 5), rr = r & 15, cc = c & 31, ob = rr * 64 + cc * 2; return st * 1024 + (ob ^ (((ob >> 9) & 1) << 5)); }
__host__ __device__ __forceinline__ void stage_rc(int b, int& R, int& C) { const int st = b / 1024, sb = b % 1024, swz = sb ^ (((sb >> 9) & 1) << 5); R = (st >> 1) * 16 + swz / 64; C = (st & 1) * 32 + (swz % 64) / 2; }
__host__ __device__ __forceinline__ int perm32(int rho) { const int n = rho >> 4, i = rho & 15; return 8 * (i >> 2) + 4 * n + (i & 3); }

struct Unit { int pm, pn, pb; };
struct Gemm { const bf16_t* A; const bf16_t* Bt; int K; const int* ridx; int tbl_off; };

struct DenseOrder {
    int nM, nN, nwg, G, c;
    __device__ void init(int nM_, int nN_, int G_, int c_) { nM = nM_; nN = nN_; nwg = nM * nN; G = G_; c = c_; }
    __device__ bool next(int i, Unit& u) const {
        const long L = (long)i * G + c; if (L >= nwg) return false;
        int wgid = (int)L; { const int q = nwg / NXCD, r = nwg % NXCD, xcd = wgid % NXCD, off = wgid / NXCD; wgid = (xcd < r ? xcd * (q + 1) : r * (q + 1) + (xcd - r) * q) + off; }
        const int nig = WGM * nN, gid = wgid / nig, fm = gid * WGM, gsz = (nM - fm) < WGM ? (nM - fm) : WGM;
        u.pm = fm + ((wgid % nig) % gsz); u.pn = (wgid % nig) / gsz; u.pb = u.pn; return true;
    }
};
struct WinOrder {
    DenseOrder dn; int nLat, nCtx, ncx, cols, G, c;
    __device__ void init(int nLat_, int nCtx_, int nN_, int ncx_, int cols_, int G_, int c_) { dn.init(nLat_, nN_, G_, c_); nLat = nLat_; nCtx = nCtx_; ncx = ncx_; cols = cols_; G = G_; c = c_; }
    __device__ bool next(int i, Unit& u) const {
        const long L = (long)i * G + c; const int nd = dn.nwg;
        if (L < nd) return dn.next(i, u);
        const int idx = (int)(L - nd); if (idx >= nCtx * ncx) return false;
        u.pm = nLat + idx / ncx; u.pn = (cols >> (4 * (idx % ncx))) & 15; u.pb = u.pn; return true;
    }
};
struct ExpertOrder {
    int nN, tpeL, tpeC, nE, G, c, nwg;
    __device__ void init(int nN_, int tpeL_, int tpeC_, int nE_, int G_, int c_) { nN = nN_; tpeL = tpeL_; tpeC = tpeC_; nE = nE_; G = G_; c = c_; nwg = nE * nN * (tpeL + tpeC); }
    __device__ bool next(int i, Unit& u) const {
        const unsigned tpe = (unsigned)(tpeL + tpeC), per = (unsigned)nN * tpe; unsigned e, j;
        if ((G & 7) == 0 && (nE & 7) == 0) { const unsigned Wx = (unsigned)G >> 3, x = (unsigned)c & 7u, r = (unsigned)c >> 3; unsigned jx = (unsigned)i * Wx + r; if (jx >= ((unsigned)nE >> 3) * per) return false;
            const unsigned ei = (jx >= per ? 1u : 0u) + (jx >= 2u * per ? 1u : 0u) + (jx >= 3u * per ? 1u : 0u); e = x + 8u * ei; j = jx - ei * per; }
        else { unsigned L = (unsigned)i * (unsigned)G + (unsigned)c; if (L >= (unsigned)nwg) return false; e = 0u; while (L >= per) { L -= per; ++e; } j = L; }
        const unsigned PW = nN < 8 ? (unsigned)nN : 8u, grp = PW * tpe; const unsigned pg = (j >= grp ? 1u : 0u) + (j >= 2u * grp ? 1u : 0u) + (j >= 3u * grp ? 1u : 0u); j -= pg * grp;
        const unsigned rest = (unsigned)nN - pg * PW, w = rest < PW ? rest : PW;
        unsigned mt;
        if (w == 8u) mt = j >> 3; else if (w == 4u) mt = j >> 2; else if (w == 6u) mt = (j * 10923u) >> 16; else { mt = 0u; for (unsigned t = j; t >= w; t -= w) ++mt; }
        const unsigned pn = pg * PW + (j - mt * w);
        u.pm = (int)(mt < (unsigned)tpeL ? e * (unsigned)tpeL + mt : (unsigned)nE * (unsigned)tpeL + e * (unsigned)tpeC + (mt - (unsigned)tpeL)); u.pn = (int)pn; u.pb = (int)(e * (unsigned)nN + pn); return true;
    }
};

typedef int i32x8 __attribute__((ext_vector_type(8)));
typedef int i32x4 __attribute__((ext_vector_type(4)));
__device__ __forceinline__ i32x8 cat8(const bf16x8 a, const bf16x8 b) { return __builtin_shufflevector(__builtin_bit_cast(i32x4, a), __builtin_bit_cast(i32x4, b), 0, 1, 2, 3, 4, 5, 6, 7); }
__device__ __forceinline__ unsigned pk4_fp8(float a, float b, float c, float d) { int r = 0; r = __builtin_amdgcn_cvt_pk_fp8_f32(a, b, r, false); r = __builtin_amdgcn_cvt_pk_fp8_f32(c, d, r, true); return (unsigned)r; }
__device__ __forceinline__ unsigned cvt_pk_bf16(float lo, float hi) { unsigned r; asm volatile("v_cvt_pk_bf16_f32 %0, %1, %2" : "=v"(r) : "v"(lo), "v"(hi)); return r; }

struct EpiBf16 {
    static constexpr bool PERM = true; static constexpr int NSTORE = 16;
    bf16_t* O; int ldc;
    __device__ __forceinline__ void operator()(const f32x4 (&acc)[2][2][4][2], const Unit& u, int wr, int wc, int fr, int fq) const {
        const int row0 = u.pm * BM + wr * 64 + fr, col0 = u.pn * BM + wc * 32 + 8 * fq;
#pragma unroll
        for (int ai = 0; ai < 2; ++ai)
#pragma unroll
            for (int m = 0; m < 4; ++m) { bf16_t* rowp = O + (size_t)(row0 + ai * HALF + m * 16) * ldc + col0;
#pragma unroll
                for (int bj = 0; bj < 2; ++bj) { const f32x4 v0 = acc[ai][bj][m][0], v1 = acc[ai][bj][m][1];
                    u32x4 w; w.x = cvt_pk_bf16(v0[0], v0[1]); w.y = cvt_pk_bf16(v0[2], v0[3]); w.z = cvt_pk_bf16(v1[0], v1[1]); w.w = cvt_pk_bf16(v1[2], v1[3]);
                    *(u32x4*)(rowp + bj * HALF) = w; } }
    }
};
struct EpiResid {
    static constexpr bool PERM = false; static constexpr int NSTORE = 32;
    float* X; const float* srcL; const float* srcC; int ldc; const float* mod; int gate_off; int NL, S, B;
    __device__ __forceinline__ void operator()(const f32x4 (&acc)[2][2][4][2], const Unit& u, int wr, int wc, int fr, int fq) const {
        const int row0 = u.pm * BM + wr * 64 + fr, col0 = u.pn * BM + wc * 32 + 4 * fq;
        const int rt = u.pm * BM; const int mi = rt < NL ? rt / S : B;
        const float* sb = rt < NL ? srcL : srcC - (size_t)NL * ldc;
        const float* gp = mod + (size_t)mi * 6 * ldc + gate_off + col0;
        f32x4 gv[2][2];
#pragma unroll
        for (int bj = 0; bj < 2; ++bj)
#pragma unroll
            for (int n = 0; n < 2; ++n) gv[bj][n] = *(const f32x4*)(gp + bj * HALF + n * 16);
#pragma unroll
        for (int ai = 0; ai < 2; ++ai)
#pragma unroll
            for (int m = 0; m < 4; ++m) { const size_t ro = (size_t)(row0 + ai * HALF + m * 16) * ldc + col0;
#pragma unroll
                for (int bj = 0; bj < 2; ++bj)
#pragma unroll
                    for (int n = 0; n < 2; ++n) *(f32x4*)(X + ro + bj * HALF + n * 16) = *(const f32x4*)(sb + ro + bj * HALF + n * 16) + gv[bj][n] * acc[ai][bj][m][n]; }
    }
};
__device__ __forceinline__ float silu_f(float x) { return x * __builtin_amdgcn_rcpf(1.0f + __expf(-x)); }
struct EpiSwiGLU8 {
    static constexpr bool PERM = true; static constexpr int NSTORE = 8;
    unsigned char* H; int ldh; float iscale, oscale;
    __device__ __forceinline__ void operator()(const f32x4 (&acc)[2][2][4][2], const Unit& u, int wr, int wc, int fr, int fq) const {
        const int row0 = u.pm * BM + wr * 64 + fr, col0 = u.pn * HALF + wc * 32 + 8 * fq; const float os = oscale * iscale;
#pragma unroll
        for (int ai = 0; ai < 2; ++ai)
#pragma unroll
            for (int m = 0; m < 4; ++m) { unsigned char* rowp = H + (size_t)(row0 + ai * HALF + m * 16) * ldh + col0;
                const f32x4 g0 = acc[ai][0][m][0] * iscale, g1 = acc[ai][0][m][1] * iscale, u0 = acc[ai][1][m][0] * os, u1 = acc[ai][1][m][1] * os;
                u32x2 w; w.x = pk4_fp8(silu_f(g0[0]) * u0[0], silu_f(g0[1]) * u0[1], silu_f(g0[2]) * u0[2], silu_f(g0[3]) * u0[3]);
                w.y = pk4_fp8(silu_f(g1[0]) * u1[0], silu_f(g1[1]) * u1[1], silu_f(g1[2]) * u1[2], silu_f(g1[3]) * u1[3]);
                *(u32x2*)rowp = w; }
    }
};
struct EpiSwiGLU8T {
    static constexpr bool PERM = true; static constexpr int NSTORE = 8;
    unsigned char* H; int nkt; float k1, cinv;
    static __device__ __forceinline__ f32x4 f(const f32x4 ag, const f32x4 au, const float k, const float ci) {
        const f32x4 e = ag * k; f32x4 t; t[0] = __builtin_amdgcn_exp2f(e[0]); t[1] = __builtin_amdgcn_exp2f(e[1]); t[2] = __builtin_amdgcn_exp2f(e[2]); t[3] = __builtin_amdgcn_exp2f(e[3]);
        const f32x4 d = t * ci + ci; f32x4 r; r[0] = __builtin_amdgcn_rcpf(d[0]); r[1] = __builtin_amdgcn_rcpf(d[1]); r[2] = __builtin_amdgcn_rcpf(d[2]); r[3] = __builtin_amdgcn_rcpf(d[3]);
        return (ag * au) * r;
    }
    __device__ __forceinline__ void operator()(const f32x4 (&acc)[2][2][4][2], const Unit& u, int wr, int wc, int fr, int fq) const {
        unsigned char* blk = H + ((size_t)u.pm * nkt + u.pn) * (size_t)(2 * HTB);
#pragma unroll
        for (int ai = 0; ai < 2; ++ai)
#pragma unroll
            for (int m = 0; m < 4; ++m) { unsigned char* rowp = blk + ai * HTB + lds_byte(wr * 64 + m * 16 + fr, wc * 16 + 4 * fq);
                const f32x4 o0 = f(acc[ai][0][m][0], acc[ai][1][m][0], k1, cinv), o1 = f(acc[ai][0][m][1], acc[ai][1][m][1], k1, cinv);
                u32x2 w; w.x = pk4_fp8(o0[0], o0[1], o0[2], o0[3]); w.y = pk4_fp8(o1[0], o1[1], o1[2], o1[3]);
                *(u32x2*)rowp = w; }
    }
};
struct EpiDown {
    static constexpr bool PERM = true; static constexpr int NSTORE = 16;
    bf16_t* Y; int ldc; const float* rowscale; float oscale;
    __device__ __forceinline__ void operator()(const f32x4 (&acc)[2][2][4][2], const Unit& u, int wr, int wc, int fr, int fq) const {
        const int row0 = u.pm * BM + wr * 64 + fr, col0 = u.pn * BM + wc * 32 + 8 * fq;
#pragma unroll
        for (int ai = 0; ai < 2; ++ai)
#pragma unroll
            for (int m = 0; m < 4; ++m) { const int row = row0 + ai * HALF + m * 16; const float g = rowscale[row] * oscale; bf16_t* rowp = Y + (size_t)row * ldc + col0;
#pragma unroll
                for (int bj = 0; bj < 2; ++bj) { const f32x4 v0 = acc[ai][bj][m][0] * g, v1 = acc[ai][bj][m][1] * g;
                    u32x4 w; w.x = cvt_pk_bf16(v0[0], v0[1]); w.y = cvt_pk_bf16(v0[2], v0[3]); w.z = cvt_pk_bf16(v1[0], v1[1]); w.w = cvt_pk_bf16(v1[2], v1[3]);
                    *(u32x4*)(rowp + bj * HALF) = w; } }
    }
};

template <class Epi, class Sched, bool F8 = false, bool SP2 = true, bool ALIGN_EPI = true, bool A_TILED = false, bool B_TILED = false, bool A_GATHER = false>
__device__ __forceinline__ void gemm_phase(PG8_LAS unsigned char* lds, const Gemm g, const Sched& S, const Epi& E) {
    int tid_ = threadIdx.x; asm volatile("" : "+v"(tid_));
    const int tid = tid_, wid = __builtin_amdgcn_readfirstlane(tid >> 6), lane = tid & 63, wr = wid >> 2, wc = wid & 3, fr = lane & 15, fq = lane >> 4;
    const int K = g.K, nt = K / BK;
    unsigned voffA[2], voffB[2];
#pragma unroll
    for (int i = 0; i < 2; ++i) { int R, C; stage_rc(tid * 16 + i * 8192, R, C); const int Rb = Epi::PERM ? ((R & ~31) + perm32(R & 31)) : R;
        voffA[i] = A_TILED ? (unsigned)(tid * 16 + i * 8192) : (unsigned)(R * K + C) * 2u; voffB[i] = B_TILED ? (unsigned)(tid * 16 + i * 8192) : (unsigned)(Rb * K + C) * 2u; }
    unsigned tadr[2], cg[2];
#pragma unroll
    for (int i = 0; i < 2; ++i) { int R, C; stage_rc(tid * 16 + i * 8192, R, C); tadr[i] = (unsigned)(g.tbl_off + R * 2); cg[i] = (unsigned)(C * 2); }
    const size_t kstepA = A_TILED ? (size_t)(2 * HTB) : (size_t)(BK * 2), kstepB = B_TILED ? (size_t)(2 * HTB) : (size_t)(BK * 2);
    const size_t hstepA = A_TILED ? (size_t)HTB : (size_t)HALF * K * 2, hstepB = B_TILED ? (size_t)HTB : (size_t)HALF * K * 2;
    const size_t tstep = (size_t)BM * K * 2;
    const unsigned ldsw = (unsigned)wid * 1024u;
    const int aoff = lds_byte(wr * 64 + fr, fq * 8), boff = lds_byte(wc * 32 + fr, fq * 8);
#define PG8_SA(b, h) (((b) * 2 + (h)) * HTB)
#define PG8_SB(b, h) ((4 + (b) * 2 + (h)) * HTB)
#define PG8_STAGE(bufoff, gbase, voff) do { _Pragma("unroll") for (int _i = 0; _i < 2; ++_i) \
        __builtin_amdgcn_global_load_lds((const unsigned*)((const char*)(gbase) + (voff)[_i]), (PG8_LAS unsigned*)(lds + (bufoff) + ldsw + _i * 8192), 16, 0, 0); } while (0)
#define PG8_STAGE_A(bufoff, ptrexpr, U, KT, H) do { if constexpr (A_GATHER) { _Pragma("unroll") for (int _i = 0; _i < 2; ++_i) { \
        const unsigned e_ = *(const PG8_LAS unsigned short*)(lds + tadr[_i] + (U) * 512 + (H) * 256); \
        __builtin_amdgcn_global_load_lds((const unsigned*)((const char*)g.A + (size_t)(KT) * (BK * 2) + (e_ * (unsigned)(K * 2) + cg[_i])), (PG8_LAS unsigned*)(lds + (bufoff) + ldsw + _i * 8192), 16, 0, 0); } } \
    else PG8_STAGE(bufoff, ptrexpr, voffA); } while (0)
#define PG8_LDA(dst, b, h) do { _Pragma("unroll") for (int m = 0; m < 4; ++m) _Pragma("unroll") for (int k = 0; k < 2; ++k) dst[m][k] = *(const PG8_LAS bf16x8*)(lds + PG8_SA(b, h) + aoff + m * 2048 + k * 1024); } while (0)
#define PG8_LDB(dst, b, h) do { _Pragma("unroll") for (int n = 0; n < 2; ++n) _Pragma("unroll") for (int k = 0; k < 2; ++k) dst[n][k] = *(const PG8_LAS bf16x8*)(lds + PG8_SB(b, h) + boff + n * 2048 + k * 1024); } while (0)
#define PG8_MMA(ai, bj, At, Bt) do { __builtin_amdgcn_s_setprio(1); _Pragma("unroll") for (int m = 0; m < 4; ++m) _Pragma("unroll") for (int n = 0; n < 2; ++n) { \
        if constexpr (F8) { const i32x8 b8_ = cat8(Bt[n][0], Bt[n][1]), a8_ = cat8(At[m][0], At[m][1]); asm volatile("v_mfma_f32_16x16x128_f8f6f4 %0, %1, %2, %0" : "+v"(acc[ai][bj][m][n]) : "v"(b8_), "v"(a8_)); } \
        else { _Pragma("unroll") for (int k = 0; k < 2; ++k) acc[ai][bj][m][n] = __builtin_amdgcn_mfma_f32_16x16x32_bf16(Bt[n][k], At[m][k], acc[ai][bj][m][n], 0, 0, 0); } } __builtin_amdgcn_s_setprio(0); } while (0)
#define PG8_WAIT_V(n) asm volatile("s_waitcnt vmcnt(" #n ")" ::: "memory")
#define PG8_WAIT_VF(f, n) asm volatile("s_cmp_eq_u32 %0, 0\n\ts_cbranch_scc0 1f\n\ts_waitcnt vmcnt(8)\n1:\n\ts_waitcnt vmcnt(%1)" :: "s"(f), "n"(n) : "memory", "scc")
#define PG8_WAIT_L(n) asm volatile("s_waitcnt lgkmcnt(" #n ")" ::: "memory")
#define PG8_BAR __builtin_amdgcn_s_barrier()
#define PG8_SCHED __builtin_amdgcn_sched_barrier(0)
    if constexpr (A_GATHER) {
        Unit u_; for (int i = tid >> 8; S.next(i, u_); i += 2) *(PG8_LAS unsigned short*)(lds + g.tbl_off + (i * 256 + (tid & 255)) * 2) = (unsigned short)g.ridx[u_.pm * BM + (tid & 255)];
        __syncthreads();
    }
    Unit cur, nxt; int ui = 0;
    if (!S.next(0, cur)) return;
    f32x4 acc[2][2][4][2];
#pragma unroll
    for (int a = 0; a < 2; ++a)
#pragma unroll
        for (int b = 0; b < 2; ++b)
#pragma unroll
            for (int m = 0; m < 4; ++m)
#pragma unroll
                for (int n = 0; n < 2; ++n) acc[a][b][m][n] = (f32x4){0.f, 0.f, 0.f, 0.f};
    bf16x8 At[4][2], B0[2][2], B1[2][2];
    const char* cA = (const char*)g.A + (size_t)cur.pm * tstep; const char* cB = (const char*)g.Bt + (size_t)cur.pb * tstep;
    if constexpr (SP2) {
        PG8_STAGE(PG8_SB(0, 0), cB, voffB); PG8_STAGE(PG8_SB(0, 1), cB + hstepB, voffB); PG8_STAGE_A(PG8_SA(0, 0), cA, 0, 0, 0); PG8_STAGE_A(PG8_SA(0, 1), cA + hstepA, 0, 0, 1);
        if (wr == 1) PG8_BAR;
        PG8_WAIT_V(2); PG8_BAR;
        PG8_STAGE(PG8_SB(1, 0), cB + kstepB, voffB); PG8_STAGE_A(PG8_SA(1, 0), cA + kstepA, 0, 1, 0); PG8_STAGE(PG8_SB(1, 1), cB + hstepB + kstepB, voffB);
        PG8_WAIT_V(6); PG8_BAR;
    } else {
    PG8_STAGE(PG8_SB(0, 0), cB, voffB); PG8_STAGE(PG8_SA(0, 0), cA, voffA); PG8_STAGE(PG8_SB(0, 1), cB + hstepB, voffB); PG8_STAGE(PG8_SA(0, 1), cA + hstepA, voffA);
    if (wr == 1) PG8_BAR;
    PG8_WAIT_V(4); PG8_BAR;
    PG8_STAGE(PG8_SB(1, 0), cB + kstepB, voffB); PG8_STAGE(PG8_SA(1, 0), cA + kstepA, voffA); PG8_STAGE(PG8_SB(1, 1), cB + hstepB + kstepB, voffB);
    PG8_WAIT_V(6); PG8_BAR;
    }
    for (;;) {
        const bool has_next = S.next(ui + 1, nxt);
        const char* nA = has_next ? (const char*)g.A + (size_t)nxt.pm * tstep : cA; const char* nB = has_next ? (const char*)g.Bt + (size_t)nxt.pb * tstep : cB;
        for (int t = 0; t < nt; t += 2) {
            const bool last = (t == nt - 2);
            const int fst = __builtin_amdgcn_readfirstlane(((t == 0) && ui > 0) ? 1 : 0);
            const char* a1 = cA + (size_t)(t + 1) * kstepA;
            const char* a2 = last ? nA : cA + (size_t)(t + 2) * kstepA; const char* b2 = last ? nB : cB + (size_t)(t + 2) * kstepB;
            const char* a3 = a2 + kstepA; const char* b3 = b2 + kstepB;
            const int u2 = last ? (has_next ? ui + 1 : ui) : ui, k2 = last ? 0 : t + 2;
            if constexpr (SP2) {
            PG8_LDB(B0, 0, 0); PG8_LDB(B1, 0, 1); PG8_SCHED; PG8_LDA(At, 0, 0); PG8_STAGE_A(PG8_SA(1, 1), a1 + hstepA, ui, t + 1, 1);
            PG8_WAIT_VF(fst, 8 + Epi::NSTORE);
            PG8_WAIT_L(0); PG8_BAR; PG8_MMA(0, 0, At, B0); PG8_MMA(0, 1, At, B1); PG8_BAR; PG8_SCHED;
            PG8_LDA(At, 0, 1); PG8_STAGE(PG8_SB(0, 0), b2, voffB); PG8_STAGE(PG8_SB(0, 1), b2 + hstepB, voffB); PG8_STAGE_A(PG8_SA(0, 0), a2, u2, k2, 0);
            PG8_WAIT_VF(fst, 8 + Epi::NSTORE);
            PG8_WAIT_L(0); PG8_BAR; PG8_MMA(1, 0, At, B0); PG8_MMA(1, 1, At, B1); PG8_BAR; PG8_SCHED;
            PG8_LDB(B0, 1, 0); PG8_LDB(B1, 1, 1); PG8_SCHED; PG8_LDA(At, 1, 0); PG8_STAGE_A(PG8_SA(0, 1), a2 + hstepA, u2, k2, 1);
            PG8_WAIT_V(8); PG8_WAIT_L(0); PG8_BAR; PG8_MMA(0, 0, At, B0); PG8_MMA(0, 1, At, B1); PG8_BAR; PG8_SCHED;
            PG8_LDA(At, 1, 1); PG8_STAGE(PG8_SB(1, 0), b3, voffB); PG8_STAGE(PG8_SB(1, 1), b3 + hstepB, voffB); PG8_STAGE_A(PG8_SA(1, 0), a3, u2, k2 + 1, 0);
            PG8_WAIT_V(8); PG8_WAIT_L(0); PG8_BAR; PG8_MMA(1, 0, At, B0); PG8_MMA(1, 1, At, B1); PG8_BAR; PG8_SCHED;
            } else {
            PG8_LDB(B0, 0, 0); PG8_SCHED; PG8_LDA(At, 0, 0); PG8_STAGE(PG8_SA(1, 1), a1 + hstepA, voffA);
            PG8_WAIT_L(8); PG8_BAR; PG8_WAIT_L(0); PG8_MMA(0, 0, At, B0); PG8_BAR; PG8_SCHED;
            PG8_LDB(B1, 0, 1); PG8_STAGE(PG8_SB(0, 0), b2, voffB);
            PG8_BAR; PG8_WAIT_L(0); PG8_MMA(0, 1, At, B1); PG8_BAR;
            PG8_LDA(At, 0, 1); PG8_STAGE(PG8_SA(0, 0), a2, voffA);
            PG8_BAR; PG8_WAIT_L(0); PG8_MMA(1, 0, At, B0); PG8_BAR; PG8_SCHED;
            PG8_STAGE(PG8_SB(0, 1), b2 + hstepB, voffB);
            PG8_WAIT_V(6); PG8_BAR; PG8_MMA(1, 1, At, B1); PG8_BAR;
            PG8_LDB(B0, 1, 0); PG8_SCHED; PG8_LDA(At, 1, 0); PG8_STAGE(PG8_SA(0, 1), a2 + hstepA, voffA);
            PG8_WAIT_L(8); PG8_BAR; PG8_WAIT_L(0); PG8_MMA(0, 0, At, B0); PG8_BAR; PG8_SCHED;
            PG8_LDB(B1, 1, 1); PG8_STAGE(PG8_SB(1, 0), b3, voffB);
            PG8_BAR; PG8_WAIT_L(0); PG8_MMA(0, 1, At, B1); PG8_BAR;
            PG8_LDA(At, 1, 1); PG8_STAGE(PG8_SA(1, 0), a3, voffA);
            PG8_BAR; PG8_WAIT_L(0); PG8_MMA(1, 0, At, B0); PG8_BAR; PG8_SCHED;
            PG8_STAGE(PG8_SB(1, 1), b3 + hstepB, voffB);
            PG8_WAIT_V(6); PG8_BAR; PG8_MMA(1, 1, At, B1); PG8_BAR;
            }
        }
        if constexpr (ALIGN_EPI) { if (wr == 0) PG8_BAR; }
        if constexpr (F8) asm volatile("s_nop 15\n\ts_nop 15" ::: "memory");
        E(acc, cur, wr, wc, fr, fq);
        if (!has_next) break;
#pragma unroll
        for (int a = 0; a < 2; ++a)
#pragma unroll
            for (int b = 0; b < 2; ++b)
#pragma unroll
                for (int m = 0; m < 4; ++m)
#pragma unroll
                    for (int n = 0; n < 2; ++n) acc[a][b][m][n] = (f32x4){0.f, 0.f, 0.f, 0.f};
        cur = nxt; cA = nA; cB = nB; ++ui;
        if constexpr (ALIGN_EPI) { if (wr == 1) PG8_BAR; }
    }
    PG8_WAIT_V(0);
    if constexpr (!ALIGN_EPI) { if (wr == 0) PG8_BAR; }
    PG8_BAR;
#undef PG8_SA
#undef PG8_SB
#undef PG8_STAGE
#undef PG8_STAGE_A
#undef PG8_LDA
#undef PG8_LDB
#undef PG8_MMA
#undef PG8_WAIT_V
#undef PG8_WAIT_VF
#undef PG8_WAIT_L
#undef PG8_BAR
#undef PG8_SCHED
}
}
#include <string.h>
constexpr int MK_THREADS = 512;
constexpr float W1_SCALE = 32.0f, W2_SCALE = 64.0f, H_SCALE = 8.0f, LOG2E = 1.4426950408889634f;
constexpr int LDS_BYTES = 163840;
constexpr int MISC_OFF = LDS_BYTES - 1024;
constexpr int TBL_OFF = 131072, TBL_UNITS = (MISC_OFF - TBL_OFF) / 512;
constexpr size_t WS_CTL_BYTES = 1u << 20;
constexpr int CW_BAR = 4096;
constexpr int CW_QUEUE = 16384;
typedef unsigned short bf16;
typedef unsigned v4u __attribute__((ext_vector_type(4)));
#define GAS __attribute__((address_space(1)))
#define LDS_WAIT() asm volatile("s_waitcnt lgkmcnt(0)" ::: "memory")

__device__ __forceinline__ unsigned pk2(float lo, float hi) { unsigned r; asm volatile("v_cvt_pk_bf16_f32 %0, %1, %2" : "=v"(r) : "v"(lo), "v"(hi)); return r; }
#define BFLO(w) __builtin_bit_cast(float, (w) << 16)
#define BFHI(w) __builtin_bit_cast(float, (w) & 0xffff0000u)
__device__ __forceinline__ float bf2f(unsigned short b) { return __builtin_bit_cast(float, (unsigned)b << 16); }

__device__ __forceinline__ void p0_transpose_item(const float* W, int K, int N, bf16* WT, int mode, LAS float* scr, int item, int lane) {
    const int nblk = N / 32, kb = item / nblk, nb = item % nblk, k0 = 64 * kb, n0 = 32 * nb;
    const int r0 = mode == 0 ? n0 : (n0 / 128) * 256 + (n0 % 128) + (mode == 2 ? 128 : 0);
#pragma unroll 8
    for (int i = 0; i < 32; ++i) { const int kk = 2 * i + (lane >> 5); scr[kk * 33 + (lane & 31)] = __builtin_nontemporal_load(W + (size_t)(k0 + kk) * N + n0 + (lane & 31)); }
    LDS_WAIT(); asm volatile("" ::: "memory");
    const int c = lane & 7;
#pragma unroll
    for (int j = 0; j < 4; ++j) { const int n = (lane >> 3) + 8 * j; const LAS float* s = scr + (8 * c) * 33 + n;
        v4u o; o.x = pk2(s[0 * 33], s[1 * 33]); o.y = pk2(s[2 * 33], s[3 * 33]); o.z = pk2(s[4 * 33], s[5 * 33]); o.w = pk2(s[6 * 33], s[7 * 33]);
        *(GAS v4u*)(WT + (size_t)(r0 + n) * K + k0 + 8 * c) = o; }
    LDS_WAIT(); asm volatile("" ::: "memory");
}
__device__ __forceinline__ void conv_block_f8(const float* W, size_t src_stride, int nmat, int K, int N, unsigned char* WT, size_t dst_stride, int mode, float scale, LAS unsigned char* lds, int G) {
    int t_ = threadIdx.x; asm volatile("" : "+v"(t_)); const int tid0 = t_, wave = __builtin_amdgcn_readfirstlane(tid0 >> 6);
    LAS float* scr = (LAS float*)lds;
    const int nkb = K / 256, nnb = N / 64, per = nkb * nnb, total = nmat * per;
    pg8::f32x4 v[8];
#define CB_SRC(it_) (W + (size_t)((it_) / per) * src_stride + (size_t)(256 * (((it_) % per) / nnb)) * N + 64 * (((it_) % per) % nnb))
#define CB_LOAD(it_) do { const float* s_ = CB_SRC(it_); const int ln_ = tid0 & 63; _Pragma("unroll") for (int i = 0; i < 8; ++i) v[i] = __builtin_nontemporal_load((const pg8::f32x4*)(s_ + (size_t)(wave * 32 + i * 4 + (ln_ >> 4)) * N + (ln_ & 15) * 4));        } while (0)
    if ((int)blockIdx.x < total) CB_LOAD((int)blockIdx.x);
    for (int it = blockIdx.x; it < total; it += G) {
        int lane = tid0 & 63; asm volatile("" : "+v"(lane));
        const int mm = it / per, r = it % per, kb = r / nnb, nb = r % nnb, k0 = 256 * kb, n0 = 64 * nb;
        unsigned char* dst = WT + (size_t)mm * dst_stride;
        const int r0 = mode == 0 ? n0 : (n0 / 128) * 256 + (n0 % 128) + (mode == 2 ? 128 : 0);
        __syncthreads();
#pragma unroll
        for (int i = 0; i < 8; ++i) { const int kk = wave * 32 + i * 4 + (lane >> 4), c4 = (lane & 15) * 4; LAS float* q = scr + kk * 65 + c4; q[0] = v[i][0] * scale; q[1] = v[i][1] * scale; q[2] = v[i][2] * scale; q[3] = v[i][3] * scale; }
        __syncthreads();
        if (it + G < total) CB_LOAD(it + G);
#pragma unroll
        for (int i = 0; i < 2; ++i) { const int blk = wave * 2 + i, rg = blk >> 2, ktl = (blk >> 1) & 1, ch = blk & 1, R16 = lane & 15, pc = lane >> 4;
            const int Rl = rg * 16 + R16, nl = (Rl & ~31) + pg8::perm32(Rl & 31), kc = ktl * 128 + ch * 64 + pc * 16; const LAS float* s = scr + kc * 65 + nl;
            v4u o; o.x = pg8::pk4_fp8(s[0 * 65], s[1 * 65], s[2 * 65], s[3 * 65]); o.y = pg8::pk4_fp8(s[4 * 65], s[5 * 65], s[6 * 65], s[7 * 65]);
            o.z = pg8::pk4_fp8(s[8 * 65], s[9 * 65], s[10 * 65], s[11 * 65]); o.w = pg8::pk4_fp8(s[12 * 65], s[13 * 65], s[14 * 65], s[15 * 65]);
            const int R = (r0 & 127) + Rl;
            *(GAS v4u*)(dst + ((size_t)(r0 >> 8) * (K >> 7) + (k0 >> 7) + ktl) * 32768 + ((r0 >> 7) & 1) * 16384 + ((R >> 4) * 2 + ch) * 1024 + (((R & 15) * 64 + pc * 16) ^ ((R & 8) ? 32 : 0))) = o; }
    }
#undef CB_SRC
#undef CB_LOAD
    __syncthreads();
}
__device__ __forceinline__ void conv_ffn_dyn(const OP& p, int l, unsigned* qctr, LAS unsigned char* lds, int lo_, int nitems_) {
    const int LO = __builtin_amdgcn_readfirstlane(lo_), NIT = LO + __builtin_amdgcn_readfirstlane(nitems_);
    typedef Dims d;
    int t_ = threadIdx.x; asm volatile("" : "+v"(t_)); const int tid0 = t_, wave = __builtin_amdgcn_readfirstlane(tid0 >> 6);
    LAS float* scr = (LAS float*)lds; LAS int* slot = (LAS int*)(lds + MISC_OFF + 512);
    constexpr int PERM_ = 176, J = d::E * PERM_, TOTAL = 3 * J;
    static_assert((d::D / 256) * (d::FF / 64) == PERM_ && (d::FF / 256) * (d::D / 64) == PERM_, "item count");
    pg8::f32x4 v[8];
#define CD_LOAD(it_) do { const int job_ = (it_) / J, loc_ = (it_) - job_ * J, mm_ = loc_ / PERM_, r_ = loc_ - mm_ * PERM_, nnb_ = job_ == 2 ? d::D / 64 : d::FF / 64, kb_ = r_ / nnb_, nb_ = r_ - kb_ * nnb_, N_ = job_ == 2 ? d::D : d::FF; \
        const float* s_ = (job_ == 0 ? p.w_gate : (job_ == 1 ? p.w_up : p.w_down)) + ((size_t)l * d::E + mm_) * ((size_t)d::D * d::FF) + (size_t)(256 * kb_) * N_ + 64 * nb_; const int ln_ = tid0 & 63; \
        _Pragma("unroll") for (int i = 0; i < 8; ++i) v[i] = __builtin_nontemporal_load((const pg8::f32x4*)(s_ + (size_t)(wave * 32 + i * 4 + (ln_ >> 4)) * N_ + (ln_ & 15) * 4)); } while (0)
    unsigned pend = 0u;
    if (tid0 == 0) { slot[0] = (int)__hip_atomic_fetch_add(qctr, 1u, __ATOMIC_RELAXED, __HIP_MEMORY_SCOPE_AGENT); pend = __hip_atomic_fetch_add(qctr, 1u, __ATOMIC_RELAXED, __HIP_MEMORY_SCOPE_AGENT); }
    __syncthreads();
    int sf_ = MISC_OFF + 512; asm volatile("" : "+v"(sf_));
    int cur = LO + __builtin_amdgcn_readfirstlane(*(LAS int*)(lds + sf_));
    if (cur < NIT) CD_LOAD(cur);
    for (int k = 0; cur < NIT; ++k) {
        int lane = tid0 & 63; asm volatile("" : "+v"(lane));
        const int job = cur / J, loc = cur - job * J, mm = loc / PERM_, r = loc - mm * PERM_, nnb = job == 2 ? d::D / 64 : d::FF / 64, kb = r / nnb, nb = r - kb * nnb, k0 = 256 * kb, n0 = 64 * nb;
        const int K = job == 2 ? d::FF : d::D; const float scale = job == 2 ? W2_SCALE : W1_SCALE;
        unsigned char* dst = (unsigned char*)(job == 2 ? p.ffnW2 : p.ffnW1) + (size_t)mm * (job == 2 ? (size_t)d::D * d::FF : (size_t)2 * d::FF * d::D);
        const int r0 = job == 2 ? n0 : (n0 / 128) * 256 + (n0 % 128) + (job == 1 ? 128 : 0);
        __syncthreads();
        if (tid0 == 0) { slot[0] = (int)pend; pend = __hip_atomic_fetch_add(qctr, 1u, __ATOMIC_RELAXED, __HIP_MEMORY_SCOPE_AGENT); }
#pragma unroll
        for (int i = 0; i < 8; ++i) { const int kk = wave * 32 + i * 4 + (lane >> 4), c4 = (lane & 15) * 4; LAS float* q = scr + kk * 65 + c4; q[0] = v[i][0] * scale; q[1] = v[i][1] * scale; q[2] = v[i][2] * scale; q[3] = v[i][3] * scale; }
        __syncthreads();
        int so_ = MISC_OFF + 512; asm volatile("" : "+v"(so_));
        const int nxt = LO + __builtin_amdgcn_readfirstlane(*(LAS int*)(lds + so_));
        if (nxt < NIT) CD_LOAD(nxt);
#pragma unroll
        for (int i = 0; i < 2; ++i) { const int blk = wave * 2 + i, rg = blk >> 2, ktl = (blk >> 1) & 1, ch = blk & 1, R16 = lane & 15, pc = lane >> 4;
            const int Rl = rg * 16 + R16, nl = (Rl & ~31) + pg8::perm32(Rl & 31), kc = ktl * 128 + ch * 64 + pc * 16; const LAS float* sp = scr + kc * 65 + nl;
            v4u o; o.x = pg8::pk4_fp8(sp[0 * 65], sp[1 * 65], sp[2 * 65], sp[3 * 65]); o.y = pg8::pk4_fp8(sp[4 * 65], sp[5 * 65], sp[6 * 65], sp[7 * 65]);
            o.z = pg8::pk4_fp8(sp[8 * 65], sp[9 * 65], sp[10 * 65], sp[11 * 65]); o.w = pg8::pk4_fp8(sp[12 * 65], sp[13 * 65], sp[14 * 65], sp[15 * 65]);
            const int R = (r0 & 127) + Rl;
            *(GAS v4u*)(dst + ((size_t)(r0 >> 8) * (K >> 7) + (k0 >> 7) + ktl) * 32768 + ((r0 >> 7) & 1) * 16384 + ((R >> 4) * 2 + ch) * 1024 + (((R & 15) * 64 + pc * 16) ^ ((R & 8) ? 32 : 0))) = o; }
        cur = nxt;
    }
#undef CD_LOAD
    __syncthreads();
}
__device__ __forceinline__ void conv_group(const float* W, size_t src_stride, int nmat, int K, int N, bf16* WT, size_t dst_stride, int mode, LAS float* scr, int gw, int ngw, int lane) {
    const int per = (K / 64) * (N / 32), total = nmat * per;
    for (int it = gw; it < total; it += ngw) { const int m = it / per, r = it % per; p0_transpose_item(W + (size_t)m * src_stride, K, N, WT + (size_t)m * dst_stride, mode, scr, r, lane); }
}

typedef float f32x4v __attribute__((ext_vector_type(4)));
typedef unsigned u32x2v __attribute__((ext_vector_type(2)));
__device__ __forceinline__ float wave_sum(float v) {
#pragma unroll
    for (int o = 1; o < 64; o <<= 1) v += __shfl_xor(v, o);
    return v;
}
__device__ __forceinline__ float fast_silu(float x) { return x * __builtin_amdgcn_rcpf(1.0f + __expf(-x)); }

__device__ __forceinline__ void phase_mod(const OP& p, LAS unsigned char* lds, int G) {
    typedef Dims d; constexpr int D6 = 6 * d::D, NS = d::B + 1, NU = d::DEPTH * (D6 / 64);
    int t_ = threadIdx.x; asm volatile("" : "+v"(t_)); const int tid = t_, lane = tid & 63, wave = __builtin_amdgcn_readfirstlane(tid >> 6);
    LAS float* sc = (LAS float*)lds;
    LAS float* red = (LAS float*)(lds + NS * d::D * 4);
    for (int i = tid; i < NS * d::D; i += MK_THREADS) { const int s = i / d::D, k = i % d::D; const float v = s < d::B ? p.c[(size_t)s * d::D + k] : p.c_ctx[k]; sc[i] = v / (1.0f + expf(-v)); }
    __syncthreads();
    for (int u = blockIdx.x; u < NU; u += G) {
        const int l = u / (D6 / 64), cb = u % (D6 / 64), col = cb * 64 + lane;
        const float* w = p.w_mod + (size_t)l * d::D * D6 + col;
        float acc[NS];
#pragma unroll
        for (int s = 0; s < NS; ++s) acc[s] = 0.f;
        const int k0 = wave * (d::D / 8);
        for (int kb = k0; kb < k0 + d::D / 8; kb += 16) {
            float wv[16];
#pragma unroll
            for (int i = 0; i < 16; ++i) wv[i] = __builtin_nontemporal_load(w + (size_t)(kb + i) * D6);
#pragma unroll
            for (int i = 0; i < 16; ++i) {
#pragma unroll
                for (int s = 0; s < NS; ++s) acc[s] += sc[s * d::D + kb + i] * wv[i]; } }
#pragma unroll
        for (int s = 0; s < NS; ++s) red[(wave * NS + s) * 64 + lane] = acc[s];
        __syncthreads();
        for (int i = tid; i < NS * 64; i += MK_THREADS) { const int s = i / 64, cl = i % 64; float v = 0.f;
#pragma unroll
            for (int wv = 0; wv < 8; ++wv) v += red[(wv * NS + s) * 64 + cl];
            p.mod[((size_t)l * NS + s) * D6 + cb * 64 + cl] = v + p.b_mod[(size_t)l * D6 + cb * 64 + cl]; }
        __syncthreads();
    }
}

template <int MODE>
__device__ __forceinline__ void phase_rows(const OP& p, LAS unsigned char* lds, int G, const float* src, const float* src2, int nrows, int lc, int ln, int which) {
    typedef Dims d;
    int t_ = threadIdx.x; asm volatile("" : "+v"(t_)); const int tid = t_, lane = tid & 63, wave = __builtin_amdgcn_readfirstlane(tid >> 6);
    LAS float* wr = (LAS float*)lds;
    if (MODE & 16) {
        const float* w = p.w_router + (size_t)ln * d::D * d::E;
        for (int i = tid; i < d::D * d::E; i += MK_THREADS) { const int k = i / d::E, e = i % d::E; wr[e * d::D + k] = w[i]; }
        __syncthreads();
    }
    const int gw = blockIdx.x * 8 + wave, ngw = G * 8, rpw = (nrows + ngw - 1) / ngw;
    const int rbeg = gw * rpw, rend = (rbeg + rpw < nrows) ? rbeg + rpw : nrows;
    if (rbeg >= rend) return;
#define ROW_PTR(r) ((r) < d::NL ? src + (size_t)(r) * d::D : src2 + (size_t)((r) - d::NL) * d::D)
    f32x4v xn[4];
#pragma unroll
    for (int j = 0; j < 4; ++j) xn[j] = *(const f32x4v*)(ROW_PTR(rbeg) + 4 * lane + 256 * j);
    int mcur = -1; f32x4v gv[4], sh[4], sc1[4], gt[4];
    int slnext = -1; if (MODE & 1) slnext = lane < d::E ? p.slotof[(size_t)rbeg * d::E + lane] : -1;
    for (int r = rbeg; r < rend; ++r) {
        const int mi = r < d::NL ? r / d::S : d::B;
        f32x4v x[4];
#pragma unroll
        for (int j = 0; j < 4; ++j) x[j] = xn[j];
        if (r + 1 < rend) {
#pragma unroll
            for (int j = 0; j < 4; ++j) xn[j] = *(const f32x4v*)(ROW_PTR(r + 1) + 4 * lane + 256 * j); }
        if (mi != mcur) {
            mcur = mi;
            if (MODE & 8) { const float* g = (which ? p.g_ffn : p.g_mix) + (size_t)ln * d::D + 4 * lane; const float* mm = p.mod + ((size_t)ln * (d::B + 1) + mi) * 6 * d::D + 4 * lane;
#pragma unroll
                for (int j = 0; j < 4; ++j) { gv[j] = *(const f32x4v*)(g + 256 * j); sh[j] = *(const f32x4v*)(mm + (which ? 3 : 0) * d::D + 256 * j); sc1[j] = *(const f32x4v*)(mm + (which ? 4 : 1) * d::D + 256 * j) + 1.0f; } }
            if (MODE & 1) { const float* gp = p.mod + ((size_t)lc * (d::B + 1) + mi) * 6 * d::D + 5 * d::D + 4 * lane;
#pragma unroll
                for (int j = 0; j < 4; ++j) gt[j] = *(const f32x4v*)(gp + 256 * j); }
        }
        if (MODE & 1) {
            f32x4v s[4];
#pragma unroll
            for (int j = 0; j < 4; ++j) s[j] = (f32x4v){0.f, 0.f, 0.f, 0.f};
            const int mysl = slnext; if (r + 1 < rend) slnext = lane < d::E ? p.slotof[(size_t)(r + 1) * d::E + lane] : -1;
            unsigned long long em = __ballot(mysl >= 0); const int ne = __builtin_amdgcn_readfirstlane(__popcll(em));
            u32x2v yw[4][4];
#pragma unroll
            for (int i = 0; i < 4; ++i) { if (i < ne) { const int e = __builtin_ctzll(em); em &= em - 1ull; const int sl = __builtin_amdgcn_readlane(mysl, e);
                const bf16* yr = p.ybufb + (size_t)sl * d::D + 4 * lane;
#pragma unroll
                for (int j = 0; j < 4; ++j) yw[i][j] = (MODE & 4) ? __builtin_nontemporal_load((const u32x2v*)(yr + 256 * j)) : *(const u32x2v*)(yr + 256 * j); } }
#pragma unroll
            for (int i = 0; i < 4; ++i) { if (i < ne) {
#pragma unroll
                for (int j = 0; j < 4; ++j) s[j] += (f32x4v){BFLO(yw[i][j].x), BFHI(yw[i][j].x), BFLO(yw[i][j].y), BFHI(yw[i][j].y)}; } }
            while (em) { const int e = __builtin_ctzll(em); em &= em - 1ull; const int sl = __builtin_amdgcn_readlane(mysl, e);
                const bf16* yr = p.ybufb + (size_t)sl * d::D + 4 * lane;
#pragma unroll
                for (int j = 0; j < 4; ++j) { const u32x2v w2 = (MODE & 4) ? __builtin_nontemporal_load((const u32x2v*)(yr + 256 * j)) : *(const u32x2v*)(yr + 256 * j); s[j] += (f32x4v){BFLO(w2.x), BFHI(w2.x), BFLO(w2.y), BFHI(w2.y)}; } }
#pragma unroll
            for (int j = 0; j < 4; ++j) x[j] += gt[j] * s[j];
        }
        if (MODE & 2) {
#pragma unroll
            for (int j = 0; j < 4; ++j) *(f32x4v*)(p.xcur + (size_t)r * d::D + 4 * lane + 256 * j) = x[j]; }
        if (MODE & 4) { if (r < d::NL) {
#pragma unroll
            for (int j = 0; j < 4; ++j) __builtin_nontemporal_store(x[j], (f32x4v*)(p.out + (size_t)r * d::D + 4 * lane + 256 * j)); } }
        if (MODE & 8) {
            float ss = 0.f;
#pragma unroll
            for (int j = 0; j < 4; ++j) ss += (x[j].x * x[j].x + x[j].y * x[j].y) + (x[j].z * x[j].z + x[j].w * x[j].w);
            const float rs = 1.0f / sqrtf(wave_sum(ss) * (1.0f / d::D) + 1e-6f);
            f32x4v h[4];
#pragma unroll
            for (int j = 0; j < 4; ++j) { h[j] = x[j] * rs * gv[j] * sc1[j] + sh[j];
                if (MODE & 16) *(unsigned*)((unsigned char*)p.hbf + (size_t)r * d::D + 4 * lane + 256 * j) = pg8::pk4_fp8(h[j].x, h[j].y, h[j].z, h[j].w);
                else { u32x2v o; o.x = pk2(h[j].x, h[j].y); o.y = pk2(h[j].z, h[j].w); *(u32x2v*)(p.hbf + (size_t)r * d::D + 4 * lane + 256 * j) = o; } }
            if (MODE & 16) {
                float lg[16]; int wo = 4 * lane; asm volatile("" : "+v"(wo));
#pragma unroll
                for (int e = 0; e < 16; ++e) { float a = 0.f;
#pragma unroll
                    for (int j = 0; j < 4; ++j) { const f32x4v wv = *(const LAS f32x4v*)(wr + e * d::D + wo + 256 * j); a += (h[j].x * wv.x + h[j].y * wv.y) + (h[j].z * wv.z + h[j].w * wv.w); }
                    lg[e] = a; }
                float v8[8], v4[4], v2[2], v1;
                { const bool hi = (lane & 32) != 0;
#pragma unroll
                  for (int i = 0; i < 8; ++i) { const float mine = hi ? lg[8 + i] : lg[i], theirs = hi ? lg[i] : lg[8 + i]; v8[i] = mine + __shfl_xor(theirs, 32); } }
                { const bool hi = (lane & 16) != 0;
#pragma unroll
                  for (int i = 0; i < 4; ++i) { const float mine = hi ? v8[4 + i] : v8[i], theirs = hi ? v8[i] : v8[4 + i]; v4[i] = mine + __shfl_xor(theirs, 16); } }
                { const bool hi = (lane & 8) != 0;
#pragma unroll
                  for (int i = 0; i < 2; ++i) { const float mine = hi ? v4[2 + i] : v4[i], theirs = hi ? v4[i] : v4[2 + i]; v2[i] = mine + __shfl_xor(theirs, 8); } }
                { const bool hi = (lane & 4) != 0; const float mine = hi ? v2[1] : v2[0], theirs = hi ? v2[0] : v2[1]; v1 = mine + __shfl_xor(theirs, 4); }
                v1 += __shfl_xor(v1, 1); v1 += __shfl_xor(v1, 2);
                float mx = v1;
#pragma unroll
                for (int o = 4; o < 64; o <<= 1) mx = fmaxf(mx, __shfl_xor(mx, o));
                const float ev = expf(v1 - mx); float sum = ev;
#pragma unroll
                for (int o = 4; o < 64; o <<= 1) sum += __shfl_xor(sum, o);
                const int e = ((lane >> 5) & 1) * 8 + ((lane >> 4) & 1) * 4 + ((lane >> 3) & 1) * 2 + ((lane >> 2) & 1);
                if ((lane & 3) == 0) p.aff[(size_t)r * d::E + e] = ev / sum;
            }
        }
    }
#undef ROW_PTR
}

__device__ __forceinline__ void router_finish(const float (&lg)[16], int lane, float* affrow) {
    float v8[8], v4[4], v2[2], v1;
    { const bool hi = (lane & 32) != 0;
#pragma unroll
      for (int i = 0; i < 8; ++i) { const float mine = hi ? lg[8 + i] : lg[i], theirs = hi ? lg[i] : lg[8 + i]; v8[i] = mine + __shfl_xor(theirs, 32); } }
    { const bool hi = (lane & 16) != 0;
#pragma unroll
      for (int i = 0; i < 4; ++i) { const float mine = hi ? v8[4 + i] : v8[i], theirs = hi ? v8[i] : v8[4 + i]; v4[i] = mine + __shfl_xor(theirs, 16); } }
    { const bool hi = (lane & 8) != 0;
#pragma unroll
      for (int i = 0; i < 2; ++i) { const float mine = hi ? v4[2 + i] : v4[i], theirs = hi ? v4[i] : v4[2 + i]; v2[i] = mine + __shfl_xor(theirs, 8); } }
    { const bool hi = (lane & 4) != 0; const float mine = hi ? v2[1] : v2[0], theirs = hi ? v2[0] : v2[1]; v1 = mine + __shfl_xor(theirs, 4); }
    v1 += __shfl_xor(v1, 1); v1 += __shfl_xor(v1, 2);
    float mx = v1;
#pragma unroll
    for (int o = 4; o < 64; o <<= 1) mx = fmaxf(mx, __shfl_xor(mx, o));
    const float ev = expf(v1 - mx); float sum = ev;
#pragma unroll
    for (int o = 4; o < 64; o <<= 1) sum += __shfl_xor(sum, o);
    const int e = ((lane >> 5) & 1) * 8 + ((lane >> 4) & 1) * 4 + ((lane >> 3) & 1) * 2 + ((lane >> 2) & 1);
    if ((lane & 3) == 0) affrow[e] = ev / sum;
}
constexpr int RT_P = 1028;
constexpr int RT_WT = 0, RT_HB = 16 * RT_P * 4, RT_PART = 2 * 16 * RT_P * 4;
__device__ __forceinline__ void phase_router(const OP& p, LAS unsigned char* lds, int G, const float* src, const float* src2, int nrows, int ln) {
    typedef Dims d;
    int t_ = threadIdx.x; asm volatile("" : "+v"(t_)); const int tid = t_, lane = tid & 63, wave = __builtin_amdgcn_readfirstlane(tid >> 6);
    LAS float* wt = (LAS float*)(lds + RT_WT); LAS float* hb = (LAS float*)(lds + RT_HB); LAS float* part = (LAS float*)(lds + RT_PART);
    { const f32x4v* w4 = (const f32x4v*)(p.w_router + (size_t)ln * d::D * d::E); f32x4v wv[8];
#pragma unroll
      for (int q = 0; q < 8; ++q) wv[q] = w4[tid + MK_THREADS * q];
#pragma unroll
      for (int q = 0; q < 8; ++q) { const int i4 = tid + MK_THREADS * q, k = i4 >> 2, e0 = (i4 & 3) * 4; wt[(e0 + 0) * RT_P + k] = wv[q].x; wt[(e0 + 1) * RT_P + k] = wv[q].y; wt[(e0 + 2) * RT_P + k] = wv[q].z; wt[(e0 + 3) * RT_P + k] = wv[q].w; } }
    __syncthreads();
    const int nblk = nrows / 16;
#define ROW_PTR(r) ((r) < d::NL ? src + (size_t)(r) * d::D : src2 + (size_t)((r) - d::NL) * d::D)
    f32x4v xn[2][4];
    if ((int)blockIdx.x < nblk) {
#pragma unroll
        for (int q = 0; q < 2; ++q)
#pragma unroll
            for (int j = 0; j < 4; ++j) xn[q][j] = *(const f32x4v*)(ROW_PTR(16 * (int)blockIdx.x + 2 * wave + q) + 4 * lane + 256 * j); }
    int mcur = -1; f32x4v gs[4], sh[4];
    for (int bi = blockIdx.x; bi < nblk; bi += G) {
        int lo_ = lane; asm volatile("" : "+v"(lo_));
        const int r = 16 * bi + 2 * wave, mi = r < d::NL ? r / d::S : d::B;
        f32x4v x[2][4];
#pragma unroll
        for (int q = 0; q < 2; ++q)
#pragma unroll
            for (int j = 0; j < 4; ++j) x[q][j] = xn[q][j];
        if (bi + G < nblk) {
#pragma unroll
            for (int q = 0; q < 2; ++q)
#pragma unroll
                for (int j = 0; j < 4; ++j) xn[q][j] = *(const f32x4v*)(ROW_PTR(16 * (bi + G) + 2 * wave + q) + 4 * lo_ + 256 * j); }
        if (mi != mcur) {
            mcur = mi; const float* g = p.g_ffn + (size_t)ln * d::D + 4 * lo_; const float* mm = p.mod + ((size_t)ln * (d::B + 1) + mi) * 6 * d::D + 4 * lo_;
#pragma unroll
            for (int j = 0; j < 4; ++j) { gs[j] = *(const f32x4v*)(g + 256 * j) * (*(const f32x4v*)(mm + 4 * d::D + 256 * j) + 1.0f); sh[j] = *(const f32x4v*)(mm + 3 * d::D + 256 * j); } }
        {
            float ssA = 0.f, ssB = 0.f;
#pragma unroll
            for (int j = 0; j < 4; ++j) { ssA += (x[0][j].x * x[0][j].x + x[0][j].y * x[0][j].y) + (x[0][j].z * x[0][j].z + x[0][j].w * x[0][j].w);
                                          ssB += (x[1][j].x * x[1][j].x + x[1][j].y * x[1][j].y) + (x[1][j].z * x[1][j].z + x[1][j].w * x[1][j].w); }
            const float rsA = 1.0f / sqrtf(wave_sum(ssA) * (1.0f / d::D) + 1e-6f), rsB = 1.0f / sqrtf(wave_sum(ssB) * (1.0f / d::D) + 1e-6f);
#pragma unroll
            for (int j = 0; j < 4; ++j) { const f32x4v hA = x[0][j] * rsA * gs[j] + sh[j], hB = x[1][j] * rsB * gs[j] + sh[j];
                *(unsigned*)((unsigned char*)p.hbf + (size_t)r * d::D + 4 * lo_ + 256 * j) = pg8::pk4_fp8(hA.x, hA.y, hA.z, hA.w);
                *(unsigned*)((unsigned char*)p.hbf + (size_t)(r + 1) * d::D + 4 * lo_ + 256 * j) = pg8::pk4_fp8(hB.x, hB.y, hB.z, hB.w);
                *(LAS f32x4v*)(hb + (2 * wave) * RT_P + 4 * lo_ + 256 * j) = hA; *(LAS f32x4v*)(hb + (2 * wave + 1) * RT_P + 4 * lo_ + 256 * j) = hB; }
        }
        __syncthreads();
        {
            const LAS float* ap = hb + (lo_ & 15) * RT_P + 128 * wave + 32 * (lo_ >> 4); const LAS float* bp = wt + (lo_ & 15) * RT_P + 128 * wave + 32 * (lo_ >> 4);
            pg8::f32x4 acc = (pg8::f32x4){0.f, 0.f, 0.f, 0.f};
#pragma unroll
            for (int t4 = 0; t4 < 8; ++t4) { const f32x4v a4 = *(const LAS f32x4v*)(ap + 4 * t4), b4 = *(const LAS f32x4v*)(bp + 4 * t4);
                acc = __builtin_amdgcn_mfma_f32_16x16x4f32(a4.x, b4.x, acc, 0, 0, 0); acc = __builtin_amdgcn_mfma_f32_16x16x4f32(a4.y, b4.y, acc, 0, 0, 0);
                acc = __builtin_amdgcn_mfma_f32_16x16x4f32(a4.z, b4.z, acc, 0, 0, 0); acc = __builtin_amdgcn_mfma_f32_16x16x4f32(a4.w, b4.w, acc, 0, 0, 0); }
#pragma unroll
            for (int rr = 0; rr < 4; ++rr) part[wave * 256 + (4 * (lo_ >> 4) + rr) * 16 + (lo_ & 15)] = acc[rr];
        }
        __syncthreads();
        if (tid < 256) {
            float v = 0.f;
#pragma unroll
            for (int w8 = 0; w8 < 8; ++w8) v += part[w8 * 256 + tid];
            float mx = v;
#pragma unroll
            for (int o = 1; o < 16; o <<= 1) mx = fmaxf(mx, __shfl_xor(mx, o));
            const float ev = expf(v - mx); float sum = ev;
#pragma unroll
            for (int o = 1; o < 16; o <<= 1) sum += __shfl_xor(sum, o);
            p.aff[(size_t)(16 * bi) * d::E + tid] = ev / sum;
        }
    }
#undef ROW_PTR
    __syncthreads();
}

__device__ __forceinline__ void phase_topk(const OP& p, LAS unsigned char* lds, int G, bool with_ctx) {
    typedef Dims d;
    int t_ = threadIdx.x; asm volatile("" : "+v"(t_)); const int tid = t_, lane = tid & 63, wave = __builtin_amdgcn_readfirstlane(tid >> 6);
    LAS unsigned* keys = (LAS unsigned*)lds;
    LAS unsigned* hist = (LAS unsigned*)(lds + 8192);
    LAS int* sel = (LAS int*)(lds + 8192 + 1024);
    LAS unsigned* scal = (LAS unsigned*)(lds + 8192 + 2048);
    const int NU = d::B * d::E * (with_ctx ? 2 : 1);
    for (int u = blockIdx.x; u < NU; u += G) {
        const int kind = u >= d::B * d::E ? 1 : 0, ue = u % (d::B * d::E), e = ue / d::B, b = ue % d::B;
        const int L = kind ? d::C : d::S, cap = kind ? d::capC : d::capL, r0 = kind ? d::NL + b * d::C : b * d::S;
        __syncthreads();
        for (int t = tid; t < L; t += MK_THREADS) keys[t] = __builtin_bit_cast(unsigned, p.aff[(size_t)(r0 + t) * d::E + e]);
        __syncthreads();
        const bool valid = 4 * tid < L; unsigned k[4];
#pragma unroll
        for (int i = 0; i < 4; ++i) k[i] = valid ? keys[4 * tid + i] : 0u;
        unsigned prefix = 0u, remaining = (unsigned)cap;
        for (int pass = 0; pass < 4; ++pass) {
            const int shift = 24 - 8 * pass;
            if (tid < 256) hist[tid] = 0u;
            __syncthreads();
            if (valid) {
#pragma unroll
                for (int i = 0; i < 4; ++i) if (pass == 0 || (k[i] >> (shift + 8)) == (prefix >> (shift + 8))) __hip_atomic_fetch_add(&hist[(k[i] >> shift) & 255u], 1u, __ATOMIC_RELAXED, __HIP_MEMORY_SCOPE_WORKGROUP); }
            __syncthreads();
            if (wave == 0) {
                unsigned c4[4]; unsigned s = 0u;
#pragma unroll
                for (int j = 0; j < 4; ++j) { c4[j] = hist[4 * lane + j]; s += c4[j]; }
                unsigned incl = s;
#pragma unroll
                for (int o = 1; o < 64; o <<= 1) { const unsigned t = __shfl_down(incl, o); if (lane + o < 64) incl += t; }
                const unsigned excl = incl - s;
                if (excl < remaining && remaining <= incl) { unsigned cum = excl; int bin = 4 * lane; unsigned nr = remaining;
#pragma unroll
                    for (int j = 3; j >= 0; --j) { if (cum + c4[j] >= remaining) { bin = 4 * lane + j; nr = remaining - cum; break; } cum += c4[j]; }
                    scal[0] = (unsigned)bin; scal[1] = nr; }
            }
            __syncthreads();
            prefix |= scal[0] << shift; remaining = scal[1];
        }
        unsigned cnt = 0u;
#pragma unroll
        for (int i = 0; i < 4; ++i) if (valid) cnt += (k[i] > prefix ? 1u : 0u) + (k[i] == prefix ? 0x10000u : 0u);
        unsigned inc = cnt;
#pragma unroll
        for (int o = 1; o < 64; o <<= 1) { const unsigned t = __shfl_up(inc, o); if (lane >= o) inc += t; }
        if (lane == 63) scal[8 + wave] = inc;
        __syncthreads();
        unsigned base = inc - cnt;
        for (int w = 0; w < wave; ++w) base += scal[8 + w];
        unsigned gpos = base & 0xffffu, epos = base >> 16; const unsigned ngt = (unsigned)cap - remaining;
        const int slot0 = (kind ? d::NSL : 0) + (e * d::B + b) * cap;
        if (valid) {
#pragma unroll
            for (int i = 0; i < 4; ++i) { const int row = r0 + 4 * tid + i; int slot = -1;
                if (k[i] > prefix) { slot = slot0 + (int)gpos; ++gpos; }
                else if (k[i] == prefix) { if (epos < remaining) slot = slot0 + (int)(ngt + epos); ++epos; }
                p.slotof[(size_t)row * d::E + e] = slot;
                if (slot >= 0) { p.rowidx[slot] = row; p.gate[slot] = __builtin_bit_cast(float, k[i]); } }
        }
        __syncthreads();
    }
    __syncthreads();
}

typedef short bf16x8v __attribute__((ext_vector_type(8)));
typedef float f32x16v __attribute__((ext_vector_type(16)));
#define MFMA32(a, b, c) __builtin_amdgcn_mfma_f32_32x32x16_bf16((a), (b), (c), 0, 0, 0)
__device__ __forceinline__ unsigned cvtpk(float lo, float hi) { unsigned r; asm volatile("v_cvt_pk_bf16_f32 %0, %1, %2" : "=v"(r) : "v"(lo), "v"(hi)); return r; }
__device__ __forceinline__ float xhalf_max(float x) { float a = x, b = x; asm volatile("s_nop 1\n\tv_permlane32_swap_b32 %0, %1" : "+v"(a), "+v"(b)); return fmaxf(a, b); }
__device__ __forceinline__ float xhalf_sum(float x) { float a = x, b = x; asm volatile("s_nop 1\n\tv_permlane32_swap_b32 %0, %1" : "+v"(a), "+v"(b)); return a + b; }
__device__ __forceinline__ int crow32(int reg, int hh) { return (reg & 3) + 8 * (reg >> 2) + 4 * hh; }

struct PrepBufs {
    bf16 *qb, *kb;
    bf16 *vTl, *vTc;
    bf16 *rqb, *rkb;
    bf16 *rkTl, *rkTc, *rvTl, *rvTc;
    bf16 *hglu;
    bf16 *sprevT;
};

constexpr int PREP_LP = 144, PREP_WL = 64 * PREP_LP;
__device__ __forceinline__ void load64(const bf16* u, int r0, int c0, LAS unsigned char* wl, int lane, float (&v)[64]) {
    v4u t[8];
#pragma unroll
    for (int i = 0; i < 8; ++i) t[i] = *(const v4u*)(u + (size_t)(r0 + 8 * i + (lane >> 3)) * Dims::INC + c0 + (lane & 7) * 8);
#pragma unroll
    for (int i = 0; i < 8; ++i) *(LAS v4u*)(wl + (8 * i + (lane >> 3)) * PREP_LP + (lane & 7) * 16) = t[i];
#pragma unroll
    for (int i = 0; i < 8; ++i) { const v4u w = *(const LAS v4u*)(wl + lane * PREP_LP + i * 16);
        v[8 * i] = BFLO(w.x); v[8 * i + 1] = BFHI(w.x); v[8 * i + 2] = BFLO(w.y); v[8 * i + 3] = BFHI(w.y); v[8 * i + 4] = BFLO(w.z); v[8 * i + 5] = BFHI(w.z); v[8 * i + 6] = BFLO(w.w); v[8 * i + 7] = BFHI(w.w); }
}
__device__ __forceinline__ void store64_row(bf16* dst0, int pitch, LAS unsigned char* wl, int lane, const float (&v)[64]) {
#pragma unroll
    for (int i = 0; i < 8; ++i) { v4u o; o.x = cvtpk(v[8 * i], v[8 * i + 1]); o.y = cvtpk(v[8 * i + 2], v[8 * i + 3]); o.z = cvtpk(v[8 * i + 4], v[8 * i + 5]); o.w = cvtpk(v[8 * i + 6], v[8 * i + 7]); *(LAS v4u*)(wl + lane * PREP_LP + i * 16) = o; }
#pragma unroll
    for (int i = 0; i < 8; ++i) { const v4u w = *(const LAS v4u*)(wl + (8 * i + (lane >> 3)) * PREP_LP + (lane & 7) * 16); *(v4u*)(dst0 + (size_t)(8 * i + (lane >> 3)) * pitch + (lane & 7) * 8) = w; }
}
__device__ __forceinline__ void store64_T(bf16* dst, int pitch, const float (&v)[64]) {
#pragma unroll
    for (int dd = 0; dd < 64; dd += 2) { const unsigned w = pk2(v[dd], v[dd + 1]); dst[(size_t)dd * pitch] = (bf16)(w & 0xffffu); dst[(size_t)(dd + 1) * pitch] = (bf16)(w >> 16); }
}
__device__ __forceinline__ void fast_sincos(float x, float* sn, float* cs) { float r = x * 0.15915494309189535f; r = r - floorf(r); *sn = __builtin_amdgcn_sinf(r); *cs = __builtin_amdgcn_cosf(r); }
template <int ITEMS>
__device__ __forceinline__ void phase_prep(const OP& p, const PrepBufs& pb, LAS unsigned char* lds, int G, int l, bool last) {
    typedef Dims d; const bf16* ub = (const bf16*)p.u;
    int t_ = threadIdx.x; asm volatile("" : "+v"(t_)); const int tid = t_, lane = tid & 63, wave = __builtin_amdgcn_readfirstlane(tid >> 6);
    constexpr int NU = d::NR / 64; LAS unsigned char* wl = lds + wave * PREP_WL;
    for (int wi = blockIdx.x * 8 + wave; wi < NU * 28; wi += G * 8) {
        const int u = wi / 28, it = wi % 28;
        const int r0 = u * 64; const int kind = r0 >= d::NL ? 1 : 0;
        const int b = kind ? (r0 - d::NL) / d::C : r0 / d::S, t0 = kind ? (r0 - d::NL) % d::C : r0 % d::S, L = kind ? d::C : d::S;
        {
            int lo_ = lane; asm volatile("" : "+v"(lo_)); const int r = r0 + lo_, t = t0 + lo_;
            float v[64];
            if (it < 10) {
                if (!(ITEMS & 1)) continue;
                const bool isq = it < 8; const int hi = isq ? it : it - 8;
                if (kind == 1 && last && isq) continue;
                load64(ub, r0, (isq ? d::oAQ : d::oAK) + hi * 64, wl, lo_, v);
                const float* g = (isq ? p.q_norm_g : p.k_norm_g) + (size_t)l * 64;
                float ss = 0.f;
#pragma unroll
                for (int k = 0; k < 64; ++k) ss += v[k] * v[k];
                const float rs = 1.0f / sqrtf(ss * (1.0f / 64.0f) + 1e-6f);
#pragma unroll
                for (int k = 0; k < 64; ++k) v[k] = v[k] * rs * g[k];
                if (kind == 0) {
                    const float prow = (float)(t / d::GRID_W), pcol = (float)(t % d::GRID_W);
#pragma unroll
                    for (int j = 0; j < 16; ++j) { const float inv = exp2f(-(float)j * (13.287712379549449f / 16.0f));
                        float sn, cs; fast_sincos(prow * inv, &sn, &cs); { const float x1 = v[j], x2 = v[j + 16]; v[j] = x1 * cs - x2 * sn; v[j + 16] = x1 * sn + x2 * cs; }
                        fast_sincos(pcol * inv, &sn, &cs); { const float x1 = v[32 + j], x2 = v[48 + j]; v[32 + j] = x1 * cs - x2 * sn; v[48 + j] = x1 * sn + x2 * cs; } }
                }
                store64_row(isq ? pb.qb + (size_t)r0 * d::AW + hi * 64 : pb.kb + (size_t)r0 * d::KVW + hi * 64, isq ? d::AW : d::KVW, wl, lo_, v);
            } else if (it < 12) {
                if (!(ITEMS & 1)) continue;
                const int hi = it - 10; load64(ub, r0, d::oAV + hi * 64, wl, lo_, v);
                store64_T((kind ? pb.vTc + ((size_t)(b * d::KVH + hi) * 64) * d::C : pb.vTl + ((size_t)(b * d::KVH + hi) * 64) * d::S) + t, L, v);
            } else if (it < 20) {
                if (!(ITEMS & 2)) continue;
                const bool isq = it < 16; const int hi = isq ? it - 12 : it - 16;
                if (kind == 1 && last && isq) continue;
                load64(ub, r0, (isq ? d::oRQ : d::oRK) + hi * 64, wl, lo_, v);
                const float pos = (float)(kind ? t : d::C + t), sc = isq ? 1.0f : 0.125f;
#pragma unroll
                for (int j = 0; j < 32; ++j) { const float inv = exp2f(-(float)j * (13.287712379549449f / 32.0f)); float sn, cs; fast_sincos(pos * inv, &sn, &cs);
                    const float x1 = v[j], x2 = v[j + 32]; v[j] = (x1 * cs - x2 * sn) * sc; v[j + 32] = (x1 * sn + x2 * cs) * sc; }
                store64_row((isq ? pb.rqb : pb.rkb) + (size_t)r0 * d::RW + hi * 64, d::RW, wl, lo_, v);
                if (!isq) store64_T((kind ? pb.rkTc + ((size_t)(b * d::RH + hi) * 64) * d::C : pb.rkTl + ((size_t)(b * d::RH + hi) * 64) * d::S) + t, L, v);
            } else if (it < 24) {
                if (!(ITEMS & 2)) continue;
                const int hi = it - 20; load64(ub, r0, d::oRV + hi * 64, wl, lo_, v);
                store64_T((kind ? pb.rvTc + ((size_t)(b * d::RH + hi) * 64) * d::C : pb.rvTl + ((size_t)(b * d::RH + hi) * 64) * d::S) + t, L, v);
            } else {
                if (!(ITEMS & 4)) continue;
                if (kind == 1 && last) continue;
                const int c0 = (it - 24) * 64;
#pragma unroll
                for (int i = 0; i < 8; ++i) { const size_t row = (size_t)(r0 + 8 * i + (lo_ >> 3)); const int cc = c0 + (lo_ & 7) * 8;
                    const v4u a = *(const v4u*)(ub + row * d::INC + d::oCV + cc), g4 = *(const v4u*)(ub + row * d::INC + d::oCV + d::CW + cc); v4u o;
#define GLU_(av, gv) ((av) * __builtin_amdgcn_rcpf(1.0f + __expf(-(gv))))
                    o.x = cvtpk(GLU_(BFLO(a.x), BFLO(g4.x)), GLU_(BFHI(a.x), BFHI(g4.x))); o.y = cvtpk(GLU_(BFLO(a.y), BFLO(g4.y)), GLU_(BFHI(a.y), BFHI(g4.y)));
                    o.z = cvtpk(GLU_(BFLO(a.z), BFLO(g4.z)), GLU_(BFHI(a.z), BFHI(g4.z))); o.w = cvtpk(GLU_(BFLO(a.w), BFLO(g4.w)), GLU_(BFHI(a.w), BFHI(g4.w)));
#undef GLU_
                    *(v4u*)(pb.hglu + row * d::CW + cc) = o; }
            }
        }
    }
}

constexpr int ATT_KP = 144, ATT_VP = 272;
constexpr int ATT_K_BYTES = 128 * ATT_KP, ATT_V_BYTES = 64 * ATT_VP;
__device__ __forceinline__ void att_unit(const OP& p, const PrepBufs& pb, LAS unsigned char* lds, int l, int kind, int b, int qblk, int kvh, int tid_, int lane_, int wave) {
    typedef Dims d;
    int tid = tid_; asm volatile("" : "+v"(tid)); const int lane = tid & 63;
    LAS unsigned char* Kt = lds; LAS unsigned char* Vt = lds + ATT_K_BYTES;
    const int g = wave >> 1, qh = wave & 1, h = kvh * d::G + g, q31 = lane & 31, hh = lane >> 5;
    const int rowq0 = (kind ? d::NL + b * d::C : b * d::S) + qblk * 128 + qh * 64;
    constexpr float SC = 0.125f * 1.4426950408889634f;
    bf16x8v qf[2][4];
#pragma unroll
    for (int qt = 0; qt < 2; ++qt)
#pragma unroll
        for (int ks = 0; ks < 4; ++ks) { const v4u w = *(const v4u*)(pb.qb + (size_t)(rowq0 + qt * 32 + q31) * d::AW + h * 64 + 16 * ks + 8 * hh); v4u o;
            o.x = cvtpk(BFLO(w.x) * SC, BFHI(w.x) * SC); o.y = cvtpk(BFLO(w.y) * SC, BFHI(w.y) * SC); o.z = cvtpk(BFLO(w.z) * SC, BFHI(w.z) * SC); o.w = cvtpk(BFLO(w.w) * SC, BFHI(w.w) * SC);
            qf[qt][ks] = __builtin_bit_cast(bf16x8v, o); }
    f32x16v O[2][2]; float m[2], lsum[2];
    const float sink2 = p.att_sink[(size_t)l * d::AH + h] * 1.4426950408889634f;
#pragma unroll
    for (int qt = 0; qt < 2; ++qt) { m[qt] = sink2; lsum[qt] = 1.0f;
#pragma unroll
        for (int dt = 0; dt < 2; ++dt)
#pragma unroll
            for (int i = 0; i < 16; ++i) O[qt][dt][i] = 0.f; }
    const int ngrp = kind ? 2 : 5;
#define AT_VALID(gi_) (!(kind == 0 && (gi_) < 3 && (qblk - 1 + (gi_) < 0 || qblk - 1 + (gi_) >= d::S / 128)))
#define AT_LOADG(gi_) do { int krow0_; const bf16* vsrc_; int voff_; \
        if (kind == 0 && (gi_) < 3) { const int kb_ = qblk - 1 + (gi_); krow0_ = b * d::S + kb_ * 128; vsrc_ = pb.vTl + ((size_t)(b * d::KVH + kvh) * 64) * d::S + kb_ * 128; voff_ = d::S; } \
        else { const int cg_ = kind ? (gi_) : (gi_) - 3; krow0_ = d::NL + b * d::C + cg_ * 128; vsrc_ = pb.vTc + ((size_t)(b * d::KVH + kvh) * 64) * d::C + cg_ * 128; voff_ = d::C; } \
        _Pragma("unroll") for (int i = 0; i < 2; ++i) { const int c = tid + MK_THREADS * i; \
            pk_[i] = *(const v4u*)(pb.kb + (size_t)(krow0_ + (c >> 3)) * d::KVW + kvh * 64 + (c & 7) * 8); pv_[i] = *(const v4u*)(vsrc_ + (size_t)(c >> 4) * voff_ + (c & 15) * 8); } } while (0)
    v4u pk_[2], pv_[2];
    int gnext = 0; while (gnext < ngrp && !AT_VALID(gnext)) ++gnext;
    if (gnext < ngrp) AT_LOADG(gnext);
    while (gnext < ngrp) {
        const int gi = gnext; const int mtype = (kind == 0 && gi == 0) ? 1 : ((kind == 0 && gi == 2) ? 2 : 0);
        __syncthreads();
#pragma unroll
        for (int i = 0; i < 2; ++i) { const int c = tid + MK_THREADS * i; *(LAS v4u*)(Kt + (c >> 3) * ATT_KP + (c & 7) * 16) = pk_[i]; *(LAS v4u*)(Vt + (c >> 4) * ATT_VP + (c & 15) * 16) = pv_[i]; }
        __syncthreads();
        ++gnext; while (gnext < ngrp && !AT_VALID(gnext)) ++gnext;
        if (gnext < ngrp) AT_LOADG(gnext);
        for (int kt = 0; kt < 4; ++kt) {
            bf16x8v kf[4];
#pragma unroll
            for (int ks = 0; ks < 4; ++ks) kf[ks] = *(const LAS bf16x8v*)(Kt + (kt * 32 + q31) * ATT_KP + (16 * ks + 8 * hh) * 2);
#pragma unroll
            for (int qt = 0; qt < 2; ++qt) {
                const int tq = 2 * qh + qt;
                if (mtype == 1 && kt < tq) continue;
                if (mtype == 2 && kt > tq) continue;
                f32x16v s;
#pragma unroll
                for (int i = 0; i < 16; ++i) s[i] = 0.f;
#pragma unroll
                for (int ks = 0; ks < 4; ++ks) s = MFMA32(kf[ks], qf[qt][ks], s);
                const int qq = tq * 32 + q31; float tmax = -3.0e38f;
#pragma unroll
                for (int i = 0; i < 16; ++i) tmax = fmaxf(tmax, s[i]);
                if (mtype != 0 && kt == tq) {
                    tmax = -3.0e38f;
#pragma unroll
                    for (int i = 0; i < 16; ++i) { const int kk = kt * 32 + crow32(i, hh); float x = s[i];
                        if (mtype == 1 ? kk < qq : kk > qq) x = -1.0e30f;
                        s[i] = x; tmax = fmaxf(tmax, x); } }
                tmax = xhalf_max(tmax);
                if (!__all(tmax <= m[qt])) {
                    const float mn = fmaxf(m[qt], tmax), corr = __builtin_amdgcn_exp2f(m[qt] - mn); m[qt] = mn; lsum[qt] *= corr;
#pragma unroll
                    for (int dt = 0; dt < 2; ++dt)
#pragma unroll
                        for (int i = 0; i < 16; ++i) O[qt][dt][i] *= corr; }
                const float mn = m[qt]; float ps = 0.f;
#pragma unroll
                for (int i = 0; i < 16; ++i) { s[i] = __builtin_amdgcn_exp2f(s[i] - mn); ps += s[i]; }
                ps = xhalf_sum(ps);
                lsum[qt] += ps;
#pragma unroll
                for (int st = 0; st < 2; ++st) {
                    v4u pk; pk.x = cvtpk(s[8 * st], s[8 * st + 1]); pk.y = cvtpk(s[8 * st + 2], s[8 * st + 3]); pk.z = cvtpk(s[8 * st + 4], s[8 * st + 5]); pk.w = cvtpk(s[8 * st + 6], s[8 * st + 7]);
                    const bf16x8v pf = __builtin_bit_cast(bf16x8v, pk);
#pragma unroll
                    for (int dt = 0; dt < 2; ++dt) {
                        const LAS unsigned char* vr = Vt + (32 * dt + q31) * ATT_VP + (kt * 32 + 16 * st + 4 * hh) * 2;
                        const u32x2v v0 = *(const LAS u32x2v*)vr, v1 = *(const LAS u32x2v*)(vr + 16);
                        v4u vv; vv.x = v0.x; vv.y = v0.y; vv.z = v1.x; vv.w = v1.y;
                        O[qt][dt] = MFMA32(__builtin_bit_cast(bf16x8v, vv), pf, O[qt][dt]);
                    }
                }
            }
        }
    }
#undef AT_VALID
#undef AT_LOADG
#pragma unroll
    for (int qt = 0; qt < 2; ++qt) { const float il = 1.0f / lsum[qt]; bf16* orow = p.mixbf + (size_t)(rowq0 + qt * 32 + q31) * d::D + h * 64;
#pragma unroll
        for (int dt = 0; dt < 2; ++dt)
#pragma unroll
            for (int rg = 0; rg < 4; ++rg) { u32x2v o; o.x = cvtpk(O[qt][dt][4 * rg] * il, O[qt][dt][4 * rg + 1] * il); o.y = cvtpk(O[qt][dt][4 * rg + 2] * il, O[qt][dt][4 * rg + 3] * il);
                *(u32x2v*)(orow + 32 * dt + 8 * rg + 4 * hh) = o; } }
}

__device__ __forceinline__ float ret_lg2(const OP& p, int l, int dir, int head) {
    const float z = p.ret_decay_logit[((size_t)l * 2 + dir) * Dims::RH + head]; return -log1pf(expf(-z)) * 1.4426950408889634f;
}
__device__ __forceinline__ bf16x8v scale_frag(const bf16x8v a, const float (&f)[8]) {
    const v4u w = __builtin_bit_cast(v4u, a); v4u o;
    o.x = cvtpk(__builtin_bit_cast(float, w.x << 16) * f[0], __builtin_bit_cast(float, w.x & 0xffff0000u) * f[1]);
    o.y = cvtpk(__builtin_bit_cast(float, w.y << 16) * f[2], __builtin_bit_cast(float, w.y & 0xffff0000u) * f[3]);
    o.z = cvtpk(__builtin_bit_cast(float, w.z << 16) * f[4], __builtin_bit_cast(float, w.z & 0xffff0000u) * f[5]);
    o.w = cvtpk(__builtin_bit_cast(float, w.w << 16) * f[6], __builtin_bit_cast(float, w.w & 0xffff0000u) * f[7]);
    return __builtin_bit_cast(bf16x8v, o);
}
__device__ __forceinline__ void ret_state_unit(const OP& p, const PrepBufs& pb, int l, int b, int head, int lane_, int wave) {
    typedef Dims d;
    int lane = lane_; asm volatile("" : "+v"(lane));
    const int dir = wave >> 2, dtile = (wave >> 1) & 1, etile = wave & 1, r31 = lane & 31, hh = lane >> 5;
    const float lg2 = ret_lg2(p, l, dir, head), cdec = exp2f(128.0f * lg2);
    f32x16v acc;
#pragma unroll
    for (int i = 0; i < 16; ++i) acc[i] = 0.f;
    const bf16* kTl = pb.rkTl + ((size_t)(b * d::RH + head) * 64 + 32 * dtile + r31) * d::S + 8 * hh; const bf16* kTc = pb.rkTc + ((size_t)(b * d::RH + head) * 64 + 32 * dtile + r31) * d::C + 8 * hh;
    const bf16* vTl = pb.rvTl + ((size_t)(b * d::RH + head) * 64 + 32 * etile + r31) * d::S + 8 * hh; const bf16* vTc = pb.rvTc + ((size_t)(b * d::RH + head) * 64 + 32 * etile + r31) * d::C + 8 * hh;
#define RS_GC(si) (dir == 0 ? (si) : ((si) < d::NCc ? d::NCc - 1 - (si) : d::NCc + (d::NCl - 1 - ((si) - d::NCc))))
#define RS_LOAD(A, B, gcv) do { const int _k = (gcv) < d::NCc ? 1 : 0, _pc = _k ? (gcv) : (gcv) - d::NCc; const bf16* _ka = (_k ? kTc : kTl) + _pc * 128; const bf16* _va = (_k ? vTc : vTl) + _pc * 128; \
        _Pragma("unroll") for (int ks = 0; ks < 8; ++ks) { A[ks] = *(const bf16x8v*)(_ka + 16 * ks); B[ks] = *(const bf16x8v*)(_va + 16 * ks); } } while (0)
    bf16x8v af[8], bfr[8], an[8], bn[8];
    RS_LOAD(af, bfr, RS_GC(0));
    for (int sidx = 0; sidx < d::NCH; ++sidx) {
        const int gc = RS_GC(sidx);
        if (sidx + 1 < d::NCH) RS_LOAD(an, bn, RS_GC(sidx + 1));
        bf16* sp = pb.sprevT + ((((size_t)(b * 2 + dir) * d::NCH + gc) * d::RH + head) * 64 + (32 * etile + r31)) * 64 + 32 * dtile;
#pragma unroll
        for (int rg = 0; rg < 4; ++rg) { u32x2v o; o.x = cvtpk(acc[4 * rg], acc[4 * rg + 1]); o.y = cvtpk(acc[4 * rg + 2], acc[4 * rg + 3]); *(u32x2v*)(sp + 8 * rg + 4 * hh) = o; }
#pragma unroll
        for (int i = 0; i < 16; ++i) acc[i] *= cdec;
        int hho = hh; asm volatile("" : "+v"(hho));
        const float e0 = lg2 * (float)(dir == 0 ? 127 - 8 * hho : 8 * hho), st1 = dir == 0 ? -lg2 : lg2;
#pragma unroll
        for (int ks = 0; ks < 8; ++ks) { float f[8];
#pragma unroll
            for (int jj = 0; jj < 8; ++jj) f[jj] = __builtin_amdgcn_exp2f(e0 + st1 * (float)(16 * ks + jj));
            acc = MFMA32(scale_frag(af[ks], f), bfr[ks], acc); }
#pragma unroll
        for (int ks = 0; ks < 8; ++ks) { af[ks] = an[ks]; bfr[ks] = bn[ks]; }
    }
#undef RS_GC
#undef RS_LOAD
}
constexpr int RO_KP = 144, RO_VP = 272, RO_K = 0, RO_V = 128 * RO_KP, RO_SF = RO_V + 64 * RO_VP, RO_SB = RO_SF + 64 * RO_KP, RO_SUB = RO_SB + 64 * RO_KP;
__device__ __forceinline__ void phase_retout(const OP& p, const PrepBufs& pb, LAS unsigned char* lds, int G, int l, bool last) {
    typedef Dims d;
    int t_ = threadIdx.x; asm volatile("" : "+v"(t_)); const int tid = t_, lane = tid & 63, wave = __builtin_amdgcn_readfirstlane(tid >> 6);
    const int sub = wave >> 2, qt = wave & 3;
    LAS unsigned char* base = lds + sub * RO_SUB;
    const int nch = last ? d::NCl : d::NCH, NU2 = d::B * nch * d::RH / 2;
    for (int u2 = blockIdx.x; u2 < NU2; u2 += G) {
        int tq_ = tid; asm volatile("" : "+v"(tq_)); const int t4 = tq_ & 255, r31 = tq_ & 31, hh = (tq_ >> 5) & 1;
        const int u = 2 * u2 + sub, head = u % d::RH, cidx = (u / d::RH) % nch, b = u / (d::RH * nch), gc = last ? cidx + d::NCc : cidx;
        const int kind = gc < d::NCc ? 1 : 0, pc = kind ? gc : gc - d::NCc, L = kind ? d::C : d::S, row0 = (kind ? d::NL + b * d::C : b * d::S) + pc * 128;
        __syncthreads();
#pragma unroll
        for (int i = 0; i < 4; ++i) { const int c = t4 + 256 * i;
            { const int key = c >> 3, part = c & 7; *(LAS v4u*)(base + RO_K + key * RO_KP + part * 16) = *(const v4u*)(pb.rkb + (size_t)(row0 + key) * d::RW + head * 64 + part * 8); }
            { const int e = c >> 4, part = c & 15; const bf16* vT = (kind ? pb.rvTc + ((size_t)(b * d::RH + head) * 64) * d::C : pb.rvTl + ((size_t)(b * d::RH + head) * 64) * d::S);
              *(LAS v4u*)(base + RO_V + e * RO_VP + part * 16) = *(const v4u*)(vT + (size_t)e * L + pc * 128 + part * 8); } }
#pragma unroll
        for (int i = 0; i < 2; ++i) { const int c = t4 + 256 * i, e = c >> 3, part = c & 7;
            *(LAS v4u*)(base + RO_SF + e * RO_KP + part * 16) = *(const v4u*)(pb.sprevT + ((((size_t)(b * 2 + 0) * d::NCH + gc) * d::RH + head) * 64 + e) * 64 + part * 8);
            *(LAS v4u*)(base + RO_SB + e * RO_KP + part * 16) = *(const v4u*)(pb.sprevT + ((((size_t)(b * 2 + 1) * d::NCH + gc) * d::RH + head) * 64 + e) * 64 + part * 8); }
        const int irow = qt * 32 + r31, row = row0 + irow;
        bf16x8v qf[4];
#pragma unroll
        for (int ks = 0; ks < 4; ++ks) qf[ks] = *(const bf16x8v*)(pb.rqb + (size_t)row * d::RW + head * 64 + 16 * ks + 8 * hh);
        u32x2v gpre[2][4];
        { const bf16* gate_ = (const bf16*)p.u + (size_t)row * d::INC + d::oRG + head * 64;
#pragma unroll
          for (int dt = 0; dt < 2; ++dt)
#pragma unroll
              for (int rg = 0; rg < 4; ++rg) gpre[dt][rg] = *(const u32x2v*)(gate_ + 32 * dt + 8 * rg + 4 * hh); }
        const float lgf = ret_lg2(p, l, 0, head), lgb = ret_lg2(p, l, 1, head);
        float cf16[16], cb16[16];
#pragma unroll
        for (int i = 0; i < 16; ++i) { const float cr = (float)((i & 3) + 8 * (i >> 2)); cf16[i] = __builtin_amdgcn_exp2f(-lgf * cr); cb16[i] = __builtin_amdgcn_exp2f(lgb * cr); }
        __syncthreads();
        f32x16v o[2];
        {
            const float cf = exp2f(lgf * (float)(irow + 1)), cb = exp2f(lgb * (float)(128 - irow));
#pragma unroll
            for (int dt = 0; dt < 2; ++dt) { f32x16v af, ab;
#pragma unroll
                for (int i = 0; i < 16; ++i) { af[i] = 0.f; ab[i] = 0.f; }
#pragma unroll
                for (int ks = 0; ks < 4; ++ks) {
                    af = MFMA32(*(const LAS bf16x8v*)(base + RO_SF + (32 * dt + r31) * RO_KP + (16 * ks + 8 * hh) * 2), qf[ks], af);
                    ab = MFMA32(*(const LAS bf16x8v*)(base + RO_SB + (32 * dt + r31) * RO_KP + (16 * ks + 8 * hh) * 2), qf[ks], ab); }
#pragma unroll
                for (int i = 0; i < 16; ++i) o[dt][i] = af[i] * cf + ab[i] * cb; }
        }
        for (int kt = 0; kt < 4; ++kt) {
            f32x16v s;
#pragma unroll
            for (int i = 0; i < 16; ++i) s[i] = 0.f;
#pragma unroll
            for (int ks = 0; ks < 4; ++ks) s = MFMA32(*(const LAS bf16x8v*)(base + RO_K + (kt * 32 + r31) * RO_KP + (16 * ks + 8 * hh) * 2), qf[ks], s);
            const int dbase = irow - (kt * 32 + 4 * hh);
            if (kt < qt) { const float tf = __builtin_amdgcn_exp2f(lgf * (float)dbase);
#pragma unroll
                for (int i = 0; i < 16; ++i) s[i] *= tf * cf16[i]; }
            else if (kt > qt) { const float tb = __builtin_amdgcn_exp2f(lgb * (float)(-dbase));
#pragma unroll
                for (int i = 0; i < 16; ++i) s[i] *= tb * cb16[i]; }
            else { const float tf = __builtin_amdgcn_exp2f(lgf * (float)dbase), tb = __builtin_amdgcn_exp2f(lgb * (float)(-dbase));
#pragma unroll
                for (int i = 0; i < 16; ++i) { const int cr = (i & 3) + 8 * (i >> 2); s[i] *= (cr <= dbase) ? tf * cf16[i] : tb * cb16[i]; } }
#pragma unroll
            for (int st = 0; st < 2; ++st) {
                v4u pk; pk.x = cvtpk(s[8 * st], s[8 * st + 1]); pk.y = cvtpk(s[8 * st + 2], s[8 * st + 3]); pk.z = cvtpk(s[8 * st + 4], s[8 * st + 5]); pk.w = cvtpk(s[8 * st + 6], s[8 * st + 7]);
                const bf16x8v pf = __builtin_bit_cast(bf16x8v, pk);
#pragma unroll
                for (int dt = 0; dt < 2; ++dt) {
                    const LAS unsigned char* vr = base + RO_V + (32 * dt + r31) * RO_VP + (kt * 32 + 16 * st + 4 * hh) * 2;
                    const u32x2v v0 = *(const LAS u32x2v*)vr, v1 = *(const LAS u32x2v*)(vr + 16);
                    v4u vv; vv.x = v0.x; vv.y = v0.y; vv.z = v1.x; vv.w = v1.y;
                    o[dt] = MFMA32(__builtin_bit_cast(bf16x8v, vv), pf, o[dt]);
                }
            }
        }
        float sm = 0.f;
#pragma unroll
        for (int dt = 0; dt < 2; ++dt)
#pragma unroll
            for (int i = 0; i < 16; ++i) sm += o[dt][i];
        sm = xhalf_sum(sm); const float mu = sm * (1.0f / 64.0f); float vr2 = 0.f;
#pragma unroll
        for (int dt = 0; dt < 2; ++dt)
#pragma unroll
            for (int i = 0; i < 16; ++i) { const float t = o[dt][i] - mu; vr2 += t * t; }
        vr2 = xhalf_sum(vr2); const float rs = 1.0f / sqrtf(vr2 * (1.0f / 64.0f) + 1e-6f);
        const float* gn = p.ret_norm_g + (size_t)l * d::RW + head * 64; bf16* orow = p.mixbf + (size_t)row * d::D + d::AW + head * 64;
#pragma unroll
        for (int dt = 0; dt < 2; ++dt)
#pragma unroll
            for (int rg = 0; rg < 4; ++rg) { const int e0 = 32 * dt + 8 * rg + 4 * hh; const f32x4v g4 = *(const f32x4v*)(gn + e0); const u32x2v tw = gpre[dt][rg]; const f32x4v t4v = (f32x4v){BFLO(tw.x), BFHI(tw.x), BFLO(tw.y), BFHI(tw.y)};
                const float y0 = (o[dt][4 * rg] - mu) * rs * g4.x * fast_silu(t4v.x), y1 = (o[dt][4 * rg + 1] - mu) * rs * g4.y * fast_silu(t4v.y);
                const float y2 = (o[dt][4 * rg + 2] - mu) * rs * g4.z * fast_silu(t4v.z), y3 = (o[dt][4 * rg + 3] - mu) * rs * g4.w * fast_silu(t4v.w);
                u32x2v ov; ov.x = cvtpk(y0, y1); ov.y = cvtpk(y2, y3); *(u32x2v*)(orow + e0) = ov; }
    }
    __syncthreads();
}
constexpr int CV_HG = 0, CV_W = 94 * 512, CV_P = CV_W + 31 * 1024;
__device__ __forceinline__ void conv_unit(const OP& p, const PrepBufs& pb, LAS unsigned char* lds, int l, int u, int tid_, int lane_, int wave) {
    typedef Dims d;
    int tid = tid_; asm volatile("" : "+v"(tid)); const int lane = tid & 63;
    const int r0 = u * 64; const int kind = r0 >= d::NL ? 1 : 0; const int t0 = kind ? (r0 - d::NL) % d::C : r0 % d::S, L = kind ? d::C : d::S;
    __syncthreads();
    {
        v4u hv[6]; f32x4v wv[4];
#pragma unroll
        for (int i = 0; i < 6; ++i) { const int c = tid + MK_THREADS * i, lr = c >> 5, part = c & 31, t = t0 - 15 + lr; const bool ok = (c < 94 * 32) && t >= 0 && t < L;
            hv[i] = *(const v4u*)(pb.hglu + (size_t)(ok ? r0 - 15 + lr : r0) * d::CW + part * 8); if (!ok) hv[i] = (v4u){0u, 0u, 0u, 0u}; }
#pragma unroll
        for (int i = 0; i < 4; ++i) { const int c = tid + MK_THREADS * i; wv[i] = *(const f32x4v*)(p.conv_w + (size_t)l * 31 * d::CW + (c < 31 * 64 ? c : 0) * 4); }
#pragma unroll
        for (int i = 0; i < 6; ++i) { const int c = tid + MK_THREADS * i; if (c < 94 * 32) *(LAS v4u*)(lds + CV_HG + (c >> 5) * 512 + (c & 31) * 16) = hv[i]; }
#pragma unroll
        for (int i = 0; i < 4; ++i) { const int c = tid + MK_THREADS * i; if (c < 31 * 64) *(LAS f32x4v*)(lds + CV_W + c * 16) = wv[i]; }
    }
    if (tid < 192) { const int which = tid >> 6, cc = tid & 63; const float* src = which == 0 ? p.conv_b : (which == 1 ? p.conv_norm_g : p.conv_norm_b);
        *(LAS f32x4v*)(lds + CV_P + which * 1024 + cc * 16) = *(const f32x4v*)(src + (size_t)l * d::CW + cc * 4); }
    __syncthreads();
    const int lr0 = 8 * wave;
    f32x4v acc[8];
    { const f32x4v bias = *(const LAS f32x4v*)(lds + CV_P + lane * 16);
#pragma unroll
      for (int i = 0; i < 8; ++i) acc[i] = bias; }
#pragma unroll
    for (int jh = 0; jh < 4; ++jh) {
        constexpr int JN = 8; const int j0 = jh * JN;
        int lw = lane; asm volatile("" : "+v"(lw));
        f32x4v w[JN];
#pragma unroll
        for (int j = 0; j < JN; ++j) w[j] = *(const LAS f32x4v*)(lds + CV_W + (j0 + j < 31 ? j0 + j : 30) * 1024 + lw * 16);
#pragma unroll
        for (int t = 0; t < 38; ++t) {
            if (t - 7 >= j0 + JN || t < j0) continue;
            const u32x2v hv = *(const LAS u32x2v*)(lds + CV_HG + (lr0 + t) * 512 + lw * 8);
            const f32x4v h4 = (f32x4v){BFLO(hv.x), BFHI(hv.x), BFLO(hv.y), BFHI(hv.y)};
#pragma unroll
            for (int i = 0; i < 8; ++i) { const int j = t - i; if (j >= j0 && j < j0 + JN && j < 31) acc[i] += h4 * w[j - j0]; }
            asm volatile("" ::: "memory");
        }
    }
    const f32x4v g4 = *(const LAS f32x4v*)(lds + CV_P + 1024 + lane * 16), b4 = *(const LAS f32x4v*)(lds + CV_P + 2048 + lane * 16);
#pragma unroll
    for (int i = 0; i < 8; ++i) {
        const float mu = wave_sum((acc[i].x + acc[i].y) + (acc[i].z + acc[i].w)) * (1.0f / d::CW); const f32x4v dv = acc[i] - mu;
        const float rs = 1.0f / sqrtf(wave_sum((dv.x * dv.x + dv.y * dv.y) + (dv.z * dv.z + dv.w * dv.w)) * (1.0f / d::CW) + 1e-6f);
        const f32x4v y = dv * rs * g4 + b4;
        u32x2v ov; ov.x = cvtpk(fast_silu(y.x), fast_silu(y.y)); ov.y = cvtpk(fast_silu(y.z), fast_silu(y.w));
        *(u32x2v*)(p.mixbf + (size_t)(r0 + lr0 + i) * d::D + d::AW + d::RW + 4 * lane) = ov;
    }
}
template <int MASK = 7> __device__ __forceinline__ void phase_mix(const OP& p, const PrepBufs& pb, LAS unsigned char* lds, unsigned* qctr, int l, bool last) {
    typedef Dims d;
    int t_ = threadIdx.x; asm volatile("" : "+v"(t_)); const int tid = t_, lane = tid & 63, wave = __builtin_amdgcn_readfirstlane(tid >> 6);
    constexpr int NS = d::B * d::RH, NUL = d::B * (d::S / 128) * d::KVH, NUC = d::B * (d::C / 128) * d::KVH;
    const int NA = NUL + (last ? 0 : NUC), NCV = (last ? d::NL : d::NR) / 64, NT = NS + NA + NCV;
    LAS int* qslot = (LAS int*)(lds + MISC_OFF + 64);
    for (;;) {
        __syncthreads();
        if (tid == 0) qslot[0] = (int)__hip_atomic_fetch_add(qctr, 1u, __ATOMIC_RELAXED, __HIP_MEMORY_SCOPE_AGENT);
        __syncthreads();
        const int v = qslot[0];
        if (v >= NT) break;
        if (v < NS) { if (MASK & 1) ret_state_unit(p, pb, l, v / d::RH, v % d::RH, lane, wave); }
        else if (v < NS + NA) { const int u = v - NS; int kind, b, qblk, kvh;
            if (u < NUL) { kind = 0; kvh = u % d::KVH; qblk = (u / d::KVH) % (d::S / 128); b = u / (d::KVH * (d::S / 128)); }
            else { const int w = u - NUL; kind = 1; kvh = w % d::KVH; qblk = (w / d::KVH) % (d::C / 128); b = w / (d::KVH * (d::C / 128)); }
            if (MASK & 2) att_unit(p, pb, lds, l, kind, b, qblk, kvh, tid, lane, wave); }
        else { if (MASK & 4) conv_unit(p, pb, lds, l, v - NS - NA, tid, lane, wave); }
    }
    __syncthreads();
}

__global__ void __launch_bounds__(MK_THREADS, 2) mk_fwd(const OP p, const PrepBufs pb, unsigned* ctl) {
    extern __shared__ __attribute__((aligned(16))) unsigned char lds[];
    if (threadIdx.x < 64) ((LAS unsigned*)(lds + MISC_OFF))[threadIdx.x] = 0u;
    __syncthreads();
    (void)xcd_barrier_post(ctl + CW_BAR, (volatile LAS unsigned*)(lds + MISC_OFF));
#define GRID_BAR() do { XcdBarrier b_; b_.bar = ctl + CW_BAR; b_.x = xb_xcc_id(); b_.st = (volatile LAS unsigned*)(lds + MISC_OFF); xcd_barrier(b_); } while (0)
    const int G = gridDim.x, ngw = G * 8;
    LAS unsigned char* ldsp = (LAS unsigned char*)lds;
#define MK_CONV(...) do { int _t = threadIdx.x; asm volatile("" : "+v"(_t)); const int lane = _t & 63, wave = __builtin_amdgcn_readfirstlane(_t >> 6); const int gw = blockIdx.x * 8 + wave; LAS float* scr = (LAS float*)(ldsp + wave * 16384); conv_group(__VA_ARGS__, scr, gw, ngw, lane); } while (0)
    const Dims& d = p.d;
    MK_CONV(p.w_in, (size_t)d.D * d.INC, d.DEPTH, d.D, d.INC, p.wInT, (size_t)d.INC * d.D, 0);
    MK_CONV(p.w_out, (size_t)d.D * d.D, d.DEPTH, d.D, d.D, p.wOutT, (size_t)d.D * d.D, 0);
    __syncthreads();
    phase_mod(p, ldsp, G); GRID_BAR();
    phase_rows<8>(p, ldsp, G, p.x, p.ctx, d.NR, 0, 0, 0); GRID_BAR();
#pragma unroll
    for (int l = 0; l < d.DEPTH; ++l) {
        const bool last = (l == d.DEPTH - 1);
        {
            pg8::Gemm g{p.hbf, p.wInT + (size_t)l * d.INC * d.D, d.D}; pg8::WinOrder S;
            if (last) S.init(d.NL / 256, (d.NR - d.NL) / 256, d.INC / 256, 3, 0x542, G, (int)blockIdx.x); else S.init(d.NR / 256, 0, d.INC / 256, 0, 0, G, (int)blockIdx.x);
            pg8::EpiBf16 E{(bf16*)p.u, d.INC};
            pg8::gemm_phase(ldsp, g, S, E);
        }
        if (l == 0) conv_ffn_dyn(p, l, ctl + CW_QUEUE + 64 * l + 32, ldsp, 0, 2 * d.E * 176); else conv_ffn_dyn(p, l, ctl + CW_QUEUE + 64 * l + 33, ldsp, 2 * d.E * 176, d.E * 176);
        GRID_BAR();
        phase_prep<7>(p, pb, ldsp, G, l, last); GRID_BAR();
        phase_mix(p, pb, ldsp, ctl + CW_QUEUE + 64 * l, l, last); GRID_BAR();
        phase_retout(p, pb, ldsp, G, l, last);
        if (l == 0) conv_ffn_dyn(p, l, ctl + CW_QUEUE + 64 * l + 35, ldsp, 2 * d.E * 176, d.E * 88);
        GRID_BAR();
        const int mrows = last ? d.NL : d.NR;
        {
            pg8::Gemm g{p.mixbf, p.wOutT + (size_t)l * d.D * d.D, d.D}; pg8::DenseOrder S; S.init(mrows / 256, d.D / 256, G, (int)blockIdx.x);
            pg8::EpiResid E{p.xcur, l == 0 ? p.x : p.xcur, l == 0 ? p.ctx : p.xcur + (size_t)d.NL * d.D, d.D, p.mod + (size_t)l * (d.B + 1) * 6 * d.D, 2 * d.D, d.NL, d.S, d.B};
            pg8::gemm_phase(ldsp, g, S, E);
            if (l == 0) conv_ffn_dyn(p, l, ctl + CW_QUEUE + 64 * l + 33, ldsp, 2 * d.E * 176 + d.E * 88, d.E * 88);
            GRID_BAR();
        }
        phase_router(p, ldsp, G, p.xcur, p.xcur + (size_t)d.NL * d.D, mrows, l); GRID_BAR();
        phase_topk(p, ldsp, G, !last); GRID_BAR();
        {
            pg8::Gemm g{p.hbf, p.ffnW1, d.D / 2, p.rowidx, TBL_OFF}; pg8::ExpertOrder S; S.init(2 * d.FF / 256, d.NSL / d.E / 256, last ? 0 : d.NSC / d.E / 256, d.E, G, (int)blockIdx.x);
            pg8::EpiSwiGLU8T E{(unsigned char*)p.hmidb, d.FF / 128, -LOG2E / W1_SCALE, W1_SCALE * W1_SCALE / H_SCALE};
            pg8::gemm_phase<pg8::EpiSwiGLU8T, pg8::ExpertOrder, true, true, true, false, true, true>(ldsp, g, S, E); GRID_BAR();
        }
        {
            pg8::Gemm g{p.hmidb, p.ffnW2, d.FF / 2}; pg8::ExpertOrder S; S.init(d.D / 256, d.NSL / d.E / 256, last ? 0 : d.NSC / d.E / 256, d.E, G, (int)blockIdx.x);
            pg8::EpiDown E{p.ybufb, d.D, p.gate, 1.0f / (W2_SCALE * H_SCALE)};
            pg8::gemm_phase<pg8::EpiDown, pg8::ExpertOrder, true, true, true, true, true>(ldsp, g, S, E);
            if (!last) conv_ffn_dyn(p, l + 1, ctl + CW_QUEUE + 64 * l + 34, ldsp, 0, 2 * d.E * 176);
            GRID_BAR();
        }
        if (!last) { phase_rows<1 | 2 | 8>(p, ldsp, G, p.xcur, p.xcur + (size_t)d.NL * d.D, d.NR, l, l + 1, 0); GRID_BAR(); }
        else { phase_rows<1 | 4>(p, ldsp, G, p.xcur, p.xcur + (size_t)d.NL * d.D, d.NL, l, l, 0); }
    }
}

static inline void fill_inputs(OP& p, void* const* d_in) {
    p.x = (const float*)d_in[0]; p.c = (const float*)d_in[1]; p.ctx = (const float*)d_in[2]; p.c_ctx = (const float*)d_in[3]; p.w_mod = (const float*)d_in[4]; p.b_mod = (const float*)d_in[5];
    p.g_mix = (const float*)d_in[6]; p.g_ffn = (const float*)d_in[7]; p.w_in = (const float*)d_in[8]; p.q_norm_g = (const float*)d_in[9]; p.k_norm_g = (const float*)d_in[10]; p.att_sink = (const float*)d_in[11];
    p.ret_decay_logit = (const float*)d_in[12]; p.ret_norm_g = (const float*)d_in[13]; p.conv_w = (const float*)d_in[14]; p.conv_b = (const float*)d_in[15]; p.conv_norm_g = (const float*)d_in[16];
    p.conv_norm_b = (const float*)d_in[17]; p.w_out = (const float*)d_in[18]; p.w_router = (const float*)d_in[19]; p.w_gate = (const float*)d_in[20]; p.w_up = (const float*)d_in[21]; p.w_down = (const float*)d_in[22];
}
static inline size_t carve_ws(OP& p, PrepBufs& pb, unsigned char* ws) {
    const Dims& d = p.d; size_t off = WS_CTL_BYTES;
    auto take = [&](size_t bytes) { void* q = ws + off; off += (bytes + 255) & ~(size_t)255; return q; };
    const size_t NR = d.NR, D = d.D;
    p.wInT = (bf16*)take((size_t)d.DEPTH * d.INC * D * 2); p.wOutT = (bf16*)take((size_t)d.DEPTH * D * D * 2);
    p.ffnW1 = (bf16*)take((size_t)d.E * 2 * d.FF * D * 2); p.ffnW2 = (bf16*)take((size_t)d.E * D * d.FF * 2);
    p.mod = (float*)take((size_t)d.DEPTH * (d.B + 1) * 6 * D * 4);
    p.xcur = (float*)take(NR * D * 4);
    p.hbf = (bf16*)take(NR * D * 2); p.mixbf = (bf16*)take(NR * D * 2);
    p.aff = (float*)take(NR * d.E * 4);
    p.rowidx = (int*)take((size_t)(d.NSL + d.NSC) * 4); p.gate = (float*)take((size_t)(d.NSL + d.NSC) * 4); p.slotof = (int*)take(NR * d.E * 4);
    { const size_t a0 = off; p.u = (float*)take(NR * d.INC * 4); p.hmidb = (bf16*)(ws + a0);
      const size_t need = (size_t)(d.NSL + d.NSC) * d.FF * 2; if (off - a0 < need) off = a0 + ((need + 255) & ~(size_t)255); }
    { const size_t b0 = off; pb.qb = (bf16*)take(NR * d.AW * 2); pb.kb = (bf16*)take(NR * d.KVW * 2);
      pb.vTl = (bf16*)take((size_t)d.B * d.KVH * 64 * d.S * 2); pb.vTc = (bf16*)take((size_t)d.B * d.KVH * 64 * d.C * 2);
      pb.rqb = (bf16*)take(NR * d.RW * 2); pb.rkb = (bf16*)take(NR * d.RW * 2);
      pb.rkTl = (bf16*)take((size_t)d.B * d.RH * 64 * d.S * 2); pb.rkTc = (bf16*)take((size_t)d.B * d.RH * 64 * d.C * 2);
      pb.rvTl = (bf16*)take((size_t)d.B * d.RH * 64 * d.S * 2); pb.rvTc = (bf16*)take((size_t)d.B * d.RH * 64 * d.C * 2);
      pb.hglu = (bf16*)take(NR * d.CW * 2); pb.sprevT = (bf16*)take((size_t)d.B * 2 * d.NCH * d.RH * 4096 * 2);
      const size_t xb = (size_t)(d.NSL + d.NSC) * D * 2; p.xe = (bf16*)(ws + b0); p.ybufb = (bf16*)(ws + b0 + ((xb + 255) & ~(size_t)255));
      const size_t need = 2 * ((xb + 255) & ~(size_t)255); if (off - b0 < need) off = b0 + need; }
    return off;
}
extern "C" void kernel_launch(void* const* d_in, const int* in_sizes, int n_in, void* d_out, int out_size, void* d_ws, size_t ws_size, hipStream_t stream) {
    (void)in_sizes; (void)n_in; (void)out_size;
    static int grid = 0;
    if (grid == 0) {
        int dev = 0, cus = 0, per_cu = 0;
        if (hipGetDevice(&dev) != hipSuccess || hipDeviceGetAttribute(&cus, hipDeviceAttributeMultiprocessorCount, dev) != hipSuccess) { fprintf(stderr, "kernel_launch: device query failed\n"); grid = -1; return; }
        if (hipFuncSetAttribute((const void*)mk_fwd, hipFuncAttributeMaxDynamicSharedMemorySize, LDS_BYTES) != hipSuccess) { fprintf(stderr, "kernel_launch: hipFuncSetAttribute failed\n"); grid = -1; return; }
        if (hipOccupancyMaxActiveBlocksPerMultiprocessor(&per_cu, (const void*)mk_fwd, MK_THREADS, LDS_BYTES) != hipSuccess || per_cu < 1) { fprintf(stderr, "kernel_launch: occupancy query says %d blocks per CU\n", per_cu); }
        (void)hipGetLastError();
        grid = cus;
    }
    if (grid < 0) return;
    OP p; memset(&p, 0, sizeof(p)); const Dims& d = p.d;
    {
        const int per = (2 * d.FF / 256) * ((d.NSL + d.NSC) / d.E / 256), tot = d.E * per;
        const int per_wg = (grid % 8 == 0 && d.E % 8 == 0) ? ((d.E / 8) * per + grid / 8 - 1) / (grid / 8) : (tot + grid - 1) / grid;
        if (per_wg > TBL_UNITS) { fprintf(stderr, "kernel_launch: %d expert-GEMM units per workgroup exceed the LDS row-index table (%d)\n", per_wg, TBL_UNITS); return; }
    }
    fill_inputs(p, d_in);
    PrepBufs pb; memset(&pb, 0, sizeof(pb));
    const size_t used = carve_ws(p, pb, (unsigned char*)d_ws);
    if (used > ws_size) { fprintf(stderr, "kernel_launch: workspace too small (%zu > %zu)\n", used, ws_size); return; }
    p.out = (float*)d_out;
    if (hipMemsetAsync(d_ws, 0, WS_CTL_BYTES, stream) != hipSuccess) { fprintf(stderr, "kernel_launch: memset failed\n"); return; }
    unsigned* ctl = (unsigned*)d_ws;
    hipLaunchKernelGGL(mk_fwd, dim3(grid), dim3(MK_THREADS), LDS_BYTES, stream, p, pb, ctl);
    const hipError_t le = hipPeekAtLastError();
    if (le != hipSuccess) fprintf(stderr, "kernel_launch: launch failed: %s\n", hipGetErrorName(le));
}
```
